# Optimizing an MI355X kernel written in HIP

```python
import jax
import jax.numpy as jnp
from jax import lax
import numpy as np

D_MODEL = 1024
BATCH = 32
SEQ = 256
DEPTH = 2
DEC_BATCH = 8
DEC_SEQ = 4096
PAST_LEN = 256

GRID_W = 64
N_EVEN = (DEPTH + 1) // 2
N_ODD = DEPTH // 2
CHUNK = 128
Q_BLOCK = 128
EPS = 1e-6
RET_HEADS = 8
RET_DK = 64
RET_DV = 128
RET_Q = RET_HEADS * RET_DK
RET_V = RET_HEADS * RET_DV
SSM_D_INNER = 1024
SSM_HEADDIM = 64
SSM_HEADS = SSM_D_INNER // SSM_HEADDIM
SSM_GROUPS = 4
SSM_RATIO = SSM_HEADS // SSM_GROUPS
SSM_STATE = 128
SSM_XBC = SSM_D_INNER + 2 * SSM_GROUPS * SSM_STATE
HYB_IN = 2 * RET_Q + 2 * RET_V + SSM_D_INNER + SSM_XBC + SSM_HEADS
HYB_MIX = RET_V + SSM_D_INNER
ATT_HEADS = 16
ATT_KV_HEADS = 4
ATT_RATIO = ATT_HEADS // ATT_KV_HEADS
ATT_HD = 64
ATT_QKV = (ATT_HEADS + 2 * ATT_KV_HEADS) * ATT_HD
ROT_FREQS = ATT_HD // 4
ROPE_BASE = 10000.0
FFN_HIDDEN = 2816

kernel_name = 'hybrid_retention_ssd_gqa_prefix_dit_step'


def rms_norm(x):
    xf = x.astype(jnp.float32)
    return (xf * lax.rsqrt(jnp.mean(xf * xf, axis=-1, keepdims=True) + EPS)).astype(x.dtype)


def head_layer_norm(x):
    xf = x.astype(jnp.float32)
    mu = jnp.mean(xf, axis=-1, keepdims=True)
    var = jnp.mean(jnp.square(xf - mu), axis=-1, keepdims=True)
    return ((xf - mu) * lax.rsqrt(var + EPS)).astype(x.dtype)


def dwconv3(x, w, b):
    xp = jnp.pad(x, ((0, 0), (1, 1), (0, 0)))
    return xp[:, :-2] * w[0] + xp[:, 1:-1] * w[1] + xp[:, 2:] * w[2] + b


def grid_rope_angles(L):
    rows = L // GRID_W
    row = jnp.repeat(jnp.arange(rows, dtype=jnp.float32), GRID_W)
    col = jnp.tile(jnp.arange(GRID_W, dtype=jnp.float32), rows)
    inv = ROPE_BASE ** (-jnp.arange(ROT_FREQS, dtype=jnp.float32) / ROT_FREQS)
    ang = jnp.stack([row[:, None] * inv, col[:, None] * inv], axis=1)
    return jnp.cos(ang), jnp.sin(ang)


def apply_rope(x, cos, sin):
    b, L, h, d = x.shape
    xr = x.astype(jnp.float32).reshape(b, L, h, 2, 2, ROT_FREQS)
    x1, x2 = xr[..., 0, :], xr[..., 1, :]
    c, s = cos[None, :, None], sin[None, :, None]
    out = jnp.stack([x1 * c - x2 * s, x1 * s + x2 * c], axis=-2)
    return out.reshape(b, L, h, d).astype(x.dtype)


def chunked_decay_scan(q, k, v, log_a, s0):
    f32 = jnp.float32
    b, L, g, dk = q.shape
    r, dv = v.shape[3], v.shape[4]
    n = L // CHUNK

    def chunks(t):
        return jnp.moveaxis(t.astype(f32).reshape((b, n, CHUNK) + t.shape[2:]), 1, 0)

    lower = jnp.tril(jnp.ones((CHUNK, CHUNK), dtype=bool))

    def step(s, inp):
        qc, kc, vc, ac = inp
        cum = jnp.cumsum(ac, axis=1)
        cum_t = jnp.moveaxis(cum, 1, -1)
        decay = jnp.exp(jnp.where(lower, cum_t[..., :, None] - cum_t[..., None, :], -jnp.inf))
        scores = jnp.einsum('bigd,bjgd->bgij', qc, kc)
        y = jnp.einsum('bgij,bgrij,bjgrv->bigrv', scores, decay, vc)
        y = y + jnp.einsum('bigd,bgrdv->bigrv', qc, s) * jnp.exp(cum)[..., None]
        last = cum_t[..., -1:]
        w = jnp.exp(last - cum_t)
        s = s * jnp.exp(last)[..., None] + jnp.einsum('bjgd,bjgrv,bgrj->bgrdv', kc, vc, w)
        return s, y

    s_fin, ys = lax.scan(step, s0.astype(f32), (chunks(q), chunks(k), chunks(v), chunks(log_a)))
    y = jnp.moveaxis(ys, 0, 1).reshape(b, L, g, r, dv)
    return y.astype(q.dtype), s_fin.astype(s0.dtype)


def hybrid_mixer(h, s_ret0, s_ssm0, w_in, w_out, log_decay, gn_gain, conv_w, conv_b,
                 a_log, dt_bias, d_skip, norm_gain):
    b, L, _ = h.shape
    cuts = np.cumsum([RET_Q, RET_Q, RET_V, RET_V, SSM_D_INNER, SSM_XBC]).tolist()
    q, k, v, g, z, xbc, dt_raw = jnp.split(h @ w_in, cuts, axis=-1)
    q = q.reshape(b, L, RET_HEADS, RET_DK)
    k = k.reshape(b, L, RET_HEADS, RET_DK) * (RET_DK ** -0.5)
    v = v.reshape(b, L, RET_HEADS, 1, RET_DV)
    xbc = jax.nn.silu(dwconv3(xbc, conv_w, conv_b))
    xs, bm, cm = jnp.split(xbc, [SSM_D_INNER, SSM_D_INNER + SSM_GROUPS * SSM_STATE], axis=-1)
    xs = xs.reshape(b, L, SSM_HEADS, SSM_HEADDIM)
    bm = bm.reshape(b, L, SSM_GROUPS, SSM_STATE)
    cm = cm.reshape(b, L, SSM_GROUPS, SSM_STATE)
    ret_ys, ret_fin, ssm_ys, ssm_fin = [], [], [], []
    for d in range(2):
        fl = (lambda t: t) if d == 0 else (lambda t: jnp.flip(t, axis=1))
        la_ret = jnp.broadcast_to(log_decay[d].astype(jnp.float32)[:, None], (b, L, RET_HEADS, 1))
        y, s = chunked_decay_scan(fl(q), fl(k), fl(v), la_ret, s_ret0[:, d][:, :, None])
        ret_ys.append(fl(y))
        ret_fin.append(s.reshape(b, RET_HEADS, RET_DK, RET_DV))
        dt = jax.nn.softplus((dt_raw + dt_bias[d]).astype(jnp.float32))
        la_ssm = (dt * -jnp.exp(a_log[d].astype(jnp.float32))).reshape(b, L, SSM_GROUPS, SSM_RATIO)
        v_ssm = (xs * dt[..., None]).reshape(b, L, SSM_GROUPS, SSM_RATIO, SSM_HEADDIM)
        s0 = s_ssm0[:, d].reshape(b, SSM_GROUPS, SSM_RATIO, SSM_STATE, SSM_HEADDIM)
        y, s = chunked_decay_scan(fl(cm), fl(bm), fl(v_ssm), fl(la_ssm), s0)
        ssm_ys.append(fl(y).reshape(b, L, SSM_HEADS, SSM_HEADDIM) + d_skip[d][:, None] * xs)
        ssm_fin.append(s.reshape(b, SSM_HEADS, SSM_STATE, SSM_HEADDIM))
    y_ret = head_layer_norm((ret_ys[0] + ret_ys[1]).reshape(b, L, RET_HEADS, RET_DV)).reshape(b, L, RET_V)
    y_ret = jax.nn.silu(g) * (y_ret * gn_gain)
    y_ssm = (ssm_ys[0] + ssm_ys[1]).reshape(b, L, SSM_D_INNER)
    y_ssm = rms_norm(y_ssm * jax.nn.silu(z)) * norm_gain
    out = jnp.concatenate([y_ret, y_ssm], axis=-1) @ w_out
    return out, jnp.stack(ret_fin, axis=1), jnp.stack(ssm_fin, axis=1)


def blocked_attention(q, k, v):
    b, L = q.shape[0], q.shape[1]
    nb = L // Q_BLOCK
    qb = jnp.moveaxis(q.reshape(b, nb, Q_BLOCK, ATT_KV_HEADS, ATT_RATIO, ATT_HD), 1, 0)
    scale = ATT_HD ** -0.5

    def one_block(qblk):
        s = jnp.einsum('bqgrd,bkgd->bgrqk', qblk, k, preferred_element_type=jnp.float32) * scale
        p = jax.nn.softmax(s, axis=-1)
        return jnp.einsum('bgrqk,bkgd->bqgrd', p.astype(v.dtype), v)

    o = lax.map(one_block, qb)
    return jnp.moveaxis(o, 0, 1).reshape(b, L, ATT_HEADS * ATT_HD)


def attention_mixer(h, kv_ctx, rope, w_qkv, q_gain, k_gain, w_o):
    b, L, _ = h.shape
    q, k, v = jnp.split(h @ w_qkv, [ATT_HEADS * ATT_HD, (ATT_HEADS + ATT_KV_HEADS) * ATT_HD], axis=-1)
    q = rms_norm(q.reshape(b, L, ATT_HEADS, ATT_HD)) * q_gain
    k = rms_norm(k.reshape(b, L, ATT_KV_HEADS, ATT_HD)) * k_gain
    v = v.reshape(b, L, ATT_KV_HEADS, ATT_HD)
    if rope is None:
        keys, vals = k, v
    else:
        q = apply_rope(q, rope[0], rope[1])
        keys = jnp.concatenate([kv_ctx[0], apply_rope(k, rope[0], rope[1])], axis=1)
        vals = jnp.concatenate([kv_ctx[1], v], axis=1)
    return blocked_attention(q, keys, vals) @ w_o, k, v


def conv_ffn(h, w_up, conv_w, conv_b, w_down):
    u = dwconv3(h @ w_up, conv_w, conv_b)
    a, val = jnp.split(u, 2, axis=-1)
    return (jax.nn.silu(a) * val) @ w_down


def trunk(x, cond, caches, P):
    b, L, _ = x.shape
    rope = None if caches is None else grid_rope_angles(L)
    ret_states, ssm_states, ks, vs = [], [], [], []
    for layer in range(DEPTH):
        mod = (jax.nn.silu(cond) @ P['w_mod'][layer] + P['b_mod'][layer])[:, None, :]
        sh1, sc1, g1, sh2, sc2, g2 = jnp.split(mod, 6, axis=-1)
        h = rms_norm(x) * P['norm_mix'][layer] * (1 + sc1) + sh1
        i = layer // 2
        if layer % 2 == 0:
            if caches is None:
                s_ret0 = jnp.zeros((b, 2, RET_HEADS, RET_DK, RET_DV), x.dtype)
                s_ssm0 = jnp.zeros((b, 2, SSM_HEADS, SSM_STATE, SSM_HEADDIM), x.dtype)
            else:
                s_ret0, s_ssm0 = caches[0][:, i], caches[1][:, i]
            y, s_ret, s_ssm = hybrid_mixer(
                h, s_ret0, s_ssm0, P['hyb_w_in'][i], P['hyb_w_out'][i], P['ret_log_decay'][i],
                P['ret_gn_gain'][i], P['ssm_conv_w'][i], P['ssm_conv_b'][i], P['ssm_a_log'][i],
                P['ssm_dt_bias'][i], P['ssm_d'][i], P['ssm_norm_gain'][i])
            ret_states.append(s_ret)
            ssm_states.append(s_ssm)
        else:
            kv_ctx = None if caches is None else (caches[2][:, i], caches[3][:, i])
            y, k_new, v_new = attention_mixer(h, kv_ctx, rope, P['attn_w_qkv'][i], P['attn_q_gain'][i],
                                              P['attn_k_gain'][i], P['attn_w_o'][i])
            ks.append(k_new)
            vs.append(v_new)
        x = x + g1 * y
        h = rms_norm(x) * P['norm_ffn'][layer] * (1 + sc2) + sh2
        x = x + g2 * conv_ffn(h, P['ffn_w_up'][layer], P['ffn_conv_w'][layer], P['ffn_conv_b'][layer],
                              P['ffn_w_down'][layer])
    return x, ret_states, ssm_states, ks, vs


def setup_inputs(seed: int = 0) -> dict:
    key = jax.random.key(seed)
    ks = iter(jax.random.split(key, 40))
    f32 = jnp.float32

    def nrm(shape, scale):
        return scale * jax.random.normal(next(ks), shape, f32)

    base_decay = jnp.log(1.0 - 2.0 ** (-5.0 - jnp.arange(RET_HEADS, dtype=f32)))
    ret_log_decay = base_decay * jnp.exp(nrm((N_EVEN, 2, RET_HEADS), 0.1))
    ssm_a_log = jnp.log(jax.random.uniform(next(ks), (N_EVEN, 2, SSM_HEADS), f32, 1.0, 16.0))
    dt0 = jnp.exp(jax.random.uniform(next(ks), (N_EVEN, 2, SSM_HEADS), f32, np.log(1e-3), np.log(1e-1)))
    ssm_dt_bias = dt0 + jnp.log(-jnp.expm1(-dt0))
    return {
        'x_prompt': nrm((BATCH, SEQ, D_MODEL), 1.0),
        'x_sample': nrm((DEC_BATCH, DEC_SEQ, D_MODEL), 1.0),
        'state_ret': nrm((DEC_BATCH, N_EVEN, 2, RET_HEADS, RET_DK, RET_DV), 0.5),
        'state_ssm': nrm((DEC_BATCH, N_EVEN, 2, SSM_HEADS, SSM_STATE, SSM_HEADDIM), 0.1),
        'cache_attn_k': nrm((DEC_BATCH, N_ODD, PAST_LEN, ATT_KV_HEADS, ATT_HD), 1.0),
        'cache_attn_v': nrm((DEC_BATCH, N_ODD, PAST_LEN, ATT_KV_HEADS, ATT_HD), 1.0),
        'c': nrm((DEC_BATCH, D_MODEL), 1.0),
        'c_ctx': nrm((D_MODEL,), 1.0),
        'w_mod': nrm((DEPTH, D_MODEL, 6 * D_MODEL), 0.5 * D_MODEL ** -0.5),
        'b_mod': nrm((DEPTH, 6 * D_MODEL), 0.02),
        'norm_mix': 1.0 + nrm((DEPTH, D_MODEL), 0.1),
        'norm_ffn': 1.0 + nrm((DEPTH, D_MODEL), 0.1),
        'ffn_w_up': nrm((DEPTH, D_MODEL, 2 * FFN_HIDDEN), D_MODEL ** -0.5),
        'ffn_conv_w': nrm((DEPTH, 3, 2 * FFN_HIDDEN), 3 ** -0.5),
        'ffn_conv_b': nrm((DEPTH, 2 * FFN_HIDDEN), 0.02),
        'ffn_w_down': nrm((DEPTH, FFN_HIDDEN, D_MODEL), FFN_HIDDEN ** -0.5),
        'hyb_w_in': nrm((N_EVEN, D_MODEL, HYB_IN), D_MODEL ** -0.5),
        'hyb_w_out': nrm((N_EVEN, HYB_MIX, D_MODEL), HYB_MIX ** -0.5),
        'ret_log_decay': ret_log_decay,
        'ret_gn_gain': 1.0 + nrm((N_EVEN, RET_V), 0.1),
        'ssm_conv_w': nrm((N_EVEN, 3, SSM_XBC), 3 ** -0.5),
        'ssm_conv_b': nrm((N_EVEN, SSM_XBC), 0.02),
        'ssm_a_log': ssm_a_log,
        'ssm_dt_bias': ssm_dt_bias,
        'ssm_d': 1.0 + nrm((N_EVEN, 2, SSM_HEADS), 0.1),
        'ssm_norm_gain': 1.0 + nrm((N_EVEN, SSM_D_INNER), 0.1),
        'attn_w_qkv': nrm((N_ODD, D_MODEL, ATT_QKV), D_MODEL ** -0.5),
        'attn_q_gain': 1.0 + nrm((N_ODD, ATT_HD), 0.1),
        'attn_k_gain': 1.0 + nrm((N_ODD, ATT_HD), 0.1),
        'attn_w_o': nrm((N_ODD, ATT_HEADS * ATT_HD, D_MODEL), (ATT_HEADS * ATT_HD) ** -0.5),
    }


def reference(x_prompt, x_sample, state_ret, state_ssm, cache_attn_k, cache_attn_v, c, c_ctx,
              w_mod, b_mod, norm_mix, norm_ffn, ffn_w_up, ffn_conv_w, ffn_conv_b, ffn_w_down,
              hyb_w_in, hyb_w_out, ret_log_decay, ret_gn_gain, ssm_conv_w, ssm_conv_b, ssm_a_log,
              ssm_dt_bias, ssm_d, ssm_norm_gain, attn_w_qkv, attn_q_gain, attn_k_gain, attn_w_o):
    P = {
        'w_mod': w_mod, 'b_mod': b_mod, 'norm_mix': norm_mix, 'norm_ffn': norm_ffn,
        'ffn_w_up': ffn_w_up, 'ffn_conv_w': ffn_conv_w, 'ffn_conv_b': ffn_conv_b, 'ffn_w_down': ffn_w_down,
        'hyb_w_in': hyb_w_in, 'hyb_w_out': hyb_w_out, 'ret_log_decay': ret_log_decay,
        'ret_gn_gain': ret_gn_gain, 'ssm_conv_w': ssm_conv_w, 'ssm_conv_b': ssm_conv_b,
        'ssm_a_log': ssm_a_log, 'ssm_dt_bias': ssm_dt_bias, 'ssm_d': ssm_d, 'ssm_norm_gain': ssm_norm_gain,
        'attn_w_qkv': attn_w_qkv, 'attn_q_gain': attn_q_gain, 'attn_k_gain': attn_k_gain, 'attn_w_o': attn_w_o,
    }
    y_prompt, rs, ss, ks, vs = trunk(x_prompt, c_ctx[None, :], None, P)
    new_state_ret = jnp.stack(rs, axis=1)
    new_state_ssm = jnp.stack(ss, axis=1)
    new_cache_attn_k = jnp.stack(ks, axis=1)
    new_cache_attn_v = jnp.stack(vs, axis=1)
    y_sample = trunk(x_sample, c, (state_ret, state_ssm, cache_attn_k, cache_attn_v), P)[0]
    return (y_prompt, y_sample, new_state_ret, new_state_ssm, new_cache_attn_k, new_cache_attn_v)
```

```cpp
#include <hip/hip_runtime.h>
#include <hip/hip_cooperative_groups.h>
#include <cstdio>
#include <cstdint>
namespace cg = cooperative_groups;
namespace pg8 {
#define PG8_LAS __attribute__((address_space(3)))
typedef unsigned short bf16_t;
typedef short bf16x8 __attribute__((ext_vector_type(8)));
typedef float f32x4 __attribute__((ext_vector_type(4)));
typedef unsigned u32x4 __attribute__((ext_vector_type(4)));
constexpr int BM = 256, BK = 64, HALF = 128, HTB = HALF * BK * 2  , STAGE_BYTES = 8 * HTB, NXCD = 8, WGM = 4;

__host__ __device__ __forceinline__ int lds_byte(int r, int c) { const int st = (r >> 4) * 2 + (c >> 5), rr = r & 15, cc = c & 31, ob = rr * 64 + cc * 2; return st * 1024 + (ob ^ (((ob >> 9) & 1) << 5)); }
__host__ __device__ __forceinline__ void stage_rc(int b, int& R, int& C) { const int st = b / 1024, sb = b % 1024, swz = sb ^ (((sb >> 9) & 1) << 5); R = (st >> 1) * 16 + swz / 64; C = (st & 1) * 32 + (swz % 64) / 2; }
__host__ __device__ __forceinline__ int perm32(int rho) { const int n = rho >> 4, i = rho & 15; return 8 * (i >> 2) + 4 * n + (i & 3); }

struct Unit { int pm, pn, pk; };
struct Gemm { const bf16_t* A; const bf16_t* Bt; int M, N, K, ks; };

struct StaticOrder {
    int nM, nN, nwg, G, c, ks;
    __host__ __device__ void init(int M, int N, int G_, int c_, int ks_ = 1) { ks = ks_; nM = M / BM; nN = N / BM * ks_; nwg = nM * nN; G = G_; c = c_; }
    __host__ __device__ bool next(int i, Unit& u) const { const long L = (long)i * G + c; if (L >= nwg) return false; decode((int)L, u); return true; }
    __host__ __device__ bool decode(int Lid, Unit& u) const {
        int wgid = Lid; { const int q = nwg / NXCD, r = nwg % NXCD, xcd = wgid % NXCD, off = wgid / NXCD; wgid = (xcd < r ? xcd * (q + 1) : r * (q + 1) + (xcd - r) * q) + off; }
        const int nig = WGM * nN, gid = wgid / nig, fm = gid * WGM, gsz = (nM - fm) < WGM ? (nM - fm) : WGM;
        u.pm = fm + ((wgid % nig) % gsz); const int pq = (wgid % nig) / gsz; u.pn = pq / ks; u.pk = pq % ks; return true;
    }
    __device__ __forceinline__ void a_ready(const Unit&) const {}
    __device__ __forceinline__ void done(const Unit&) const {}
};
struct SkewOrder {
    StaticOrder B; int c, G;
    __host__ __device__ void init(int M, int N, int G_, int c_) { B.init(M, N, G_, c_); c = c_; G = G_; }
    __host__ __device__ bool next(int i, Unit& u) const {
        long L;
        if (G != 256) L = (long)i * G + c;
        else if (c < 64) { if (i >= 5) return false; L = (long)i * 64 + c; }
        else L = 320 + (c - 64) + (long)i * 192;
        if (L >= B.nwg) return false;
        B.decode((int)L, u); return true;
    }
    __device__ __forceinline__ void a_ready(const Unit&) const {}
    __device__ __forceinline__ void done(const Unit&) const {}
};

__device__ __forceinline__ unsigned cvt_pk_bf16(float lo, float hi) { unsigned r; asm volatile("v_cvt_pk_bf16_f32 %0, %1, %2" : "=v"(r) : "v"(lo), "v"(hi)); return r; }
typedef float f32x2 __attribute__((ext_vector_type(2)));
template <class Epi, class Sched, bool ALIGN_EPI = false, bool SP2 = false>
__device__ __forceinline__ void gemm_phase(PG8_LAS unsigned char* lds, const Gemm g, const Sched& S, const Epi& E, const int tid) {
    const int  wid = __builtin_amdgcn_readfirstlane(tid >> 6), lane = tid & 63, wr = wid >> 2, wc = wid & 3, fr = lane & 15, fq = lane >> 4;
    const int K = g.K, nt = K / g.ks / BK; const size_t kext = (size_t)(K / g.ks) * 2;
    unsigned voffA[2], voffB[2];
#pragma unroll
    for (int i = 0; i < 2; ++i) { int R, C; stage_rc(tid * 16 + i * 8192, R, C); const int Rb = Epi::PERM ? ((R & ~31) + perm32(R & 31)) : R;
        voffA[i] = (unsigned)(R * K + C) * 2u; voffB[i] = (unsigned)(Rb * K + C) * 2u; }
    const size_t kstep = (size_t)(BK * 2);
    const size_t hstep = (size_t)HALF * K * 2;
    const size_t tstep = 2 * hstep;
    const unsigned ldsw = (unsigned)wid * 1024u;
    const int aoff = lds_byte(wr * 64 + fr, fq * 8), boff = lds_byte(wc * 32 + fr, fq * 8);
#define PG8_SA(b, h) (((b) * 2 + (h)) * HTB)
#define PG8_SB(b, h) ((4 + (b) * 2 + (h)) * HTB)
#define PG8_STAGE(bufoff, gbase, voff) do { _Pragma("unroll") for (int _i = 0; _i < 2; ++_i) \
        __builtin_amdgcn_global_load_lds((const unsigned*)((const char*)(gbase) + (voff)[_i]), (PG8_LAS unsigned*)(lds + (bufoff) + ldsw + _i * 8192), 16, 0, 0); } while (0)
#define PG8_LDA(dst, b, h) do { _Pragma("unroll") for (int m = 0; m < 4; ++m) _Pragma("unroll") for (int k = 0; k < 2; ++k) dst[m][k] = *(const PG8_LAS bf16x8*)(lds + PG8_SA(b, h) + aoff + m * 2048 + k * 1024); } while (0)
#define PG8_LDB(dst, b, h) do { _Pragma("unroll") for (int n = 0; n < 2; ++n) _Pragma("unroll") for (int k = 0; k < 2; ++k) dst[n][k] = *(const PG8_LAS bf16x8*)(lds + PG8_SB(b, h) + boff + n * 2048 + k * 1024); } while (0)
#define PG8_MMA(ai, bj, At, Bt) do { __builtin_amdgcn_s_setprio(1); _Pragma("unroll") for (int m = 0; m < 4; ++m) _Pragma("unroll") for (int n = 0; n < 2; ++n) _Pragma("unroll") for (int k = 0; k < 2; ++k) \
        acc[ai][bj][m][n] = __builtin_amdgcn_mfma_f32_16x16x32_bf16(Bt[n][k], At[m][k], acc[ai][bj][m][n], 0, 0, 0); __builtin_amdgcn_s_setprio(0); } while (0)
#define PG8_WAIT_V(n) asm volatile("s_waitcnt vmcnt(" #n ")" ::: "memory")
#define PG8_WAIT_L(n) asm volatile("s_waitcnt lgkmcnt(" #n ")" ::: "memory")
#define PG8_BAR __builtin_amdgcn_s_barrier()
#define PG8_SCHED __builtin_amdgcn_sched_barrier(0)
    Unit cur, nxt; int ui = 0;
    if (!S.next(0, cur)) return;
    f32x4 acc[2][2][4][2];
#pragma unroll
    for (int a = 0; a < 2; ++a)
#pragma unroll
        for (int b = 0; b < 2; ++b)
#pragma unroll
            for (int m = 0; m < 4; ++m)
#pragma unroll
                for (int n = 0; n < 2; ++n) acc[a][b][m][n] = (f32x4){0.f, 0.f, 0.f, 0.f};
    bf16x8 At[4][2], B0[2][2], B1[2][2];
    const char* cA = (const char*)g.A + (size_t)cur.pm * tstep + cur.pk * kext; const char* cB = (const char*)g.Bt + (size_t)cur.pn * tstep + cur.pk * kext;
    S.a_ready(cur);
    if constexpr (SP2) {
        PG8_STAGE(PG8_SB(0, 0), cB, voffB); PG8_STAGE(PG8_SB(0, 1), cB + hstep, voffB); PG8_STAGE(PG8_SA(0, 0), cA, voffA); PG8_STAGE(PG8_SA(0, 1), cA + hstep, voffA);
        if (wr == 1) PG8_BAR;
        PG8_WAIT_V(2); PG8_BAR;
        PG8_STAGE(PG8_SB(1, 0), cB + kstep, voffB); PG8_STAGE(PG8_SA(1, 0), cA + kstep, voffA); PG8_STAGE(PG8_SB(1, 1), cB + hstep + kstep, voffB);
        PG8_WAIT_V(6); PG8_BAR;
    } else {
        PG8_STAGE(PG8_SB(0, 0), cB, voffB); PG8_STAGE(PG8_SA(0, 0), cA, voffA); PG8_STAGE(PG8_SB(0, 1), cB + hstep, voffB); PG8_STAGE(PG8_SA(0, 1), cA + hstep, voffA);
        if (wr == 1) PG8_BAR;
        PG8_WAIT_V(4); PG8_BAR;
        PG8_STAGE(PG8_SB(1, 0), cB + kstep, voffB); PG8_STAGE(PG8_SA(1, 0), cA + kstep, voffA); PG8_STAGE(PG8_SB(1, 1), cB + hstep + kstep, voffB);
        PG8_WAIT_V(6); PG8_BAR;
    }
    for (;;) {
        const bool has_next = S.next(ui + 1, nxt);
        const char* nA = has_next ? (const char*)g.A + (size_t)nxt.pm * tstep + nxt.pk * kext : cA; const char* nB = has_next ? (const char*)g.Bt + (size_t)nxt.pn * tstep + nxt.pk * kext : cB;
        for (int t = 0; t < nt; t += 2) {
            const bool last = (t == nt - 2);
            const char* a1 = cA + (size_t)(t + 1) * kstep;
            const char* a2 = last ? nA : cA + (size_t)(t + 2) * kstep; const char* b2 = last ? nB : cB + (size_t)(t + 2) * kstep;
            const char* a3 = a2 + kstep; const char* b3 = b2 + kstep;
            if (last && has_next) S.a_ready(nxt);
            if constexpr (SP2) {
            PG8_LDB(B0, 0, 0); PG8_LDB(B1, 0, 1); PG8_SCHED; PG8_LDA(At, 0, 0); PG8_STAGE(PG8_SA(1, 1), a1 + hstep, voffA);
            PG8_WAIT_V(8); PG8_WAIT_L(0); PG8_BAR; PG8_MMA(0, 0, At, B0); PG8_MMA(0, 1, At, B1); PG8_BAR; PG8_SCHED;
            PG8_LDA(At, 0, 1); PG8_STAGE(PG8_SB(0, 0), b2, voffB); PG8_STAGE(PG8_SB(0, 1), b2 + hstep, voffB); PG8_STAGE(PG8_SA(0, 0), a2, voffA);
            PG8_WAIT_V(8); PG8_WAIT_L(0); PG8_BAR; PG8_MMA(1, 0, At, B0); PG8_MMA(1, 1, At, B1); PG8_BAR; PG8_SCHED;
            PG8_LDB(B0, 1, 0); PG8_LDB(B1, 1, 1); PG8_SCHED; PG8_LDA(At, 1, 0); PG8_STAGE(PG8_SA(0, 1), a2 + hstep, voffA);
            PG8_WAIT_V(8); PG8_WAIT_L(0); PG8_BAR; PG8_MMA(0, 0, At, B0); PG8_MMA(0, 1, At, B1); PG8_BAR; PG8_SCHED;
            PG8_LDA(At, 1, 1); PG8_STAGE(PG8_SB(1, 0), b3, voffB); PG8_STAGE(PG8_SB(1, 1), b3 + hstep, voffB); PG8_STAGE(PG8_SA(1, 0), a3, voffA);
            PG8_WAIT_V(8); PG8_WAIT_L(0); PG8_BAR; PG8_MMA(1, 0, At, B0); PG8_MMA(1, 1, At, B1); PG8_BAR; PG8_SCHED;
            } else {
            PG8_LDB(B0, 0, 0); PG8_SCHED; PG8_LDA(At, 0, 0); PG8_STAGE(PG8_SA(1, 1), a1 + hstep, voffA);
            PG8_WAIT_L(8); PG8_BAR; PG8_WAIT_L(0); PG8_MMA(0, 0, At, B0); PG8_BAR; PG8_SCHED;
            PG8_LDB(B1, 0, 1); PG8_STAGE(PG8_SB(0, 0), b2, voffB);
            PG8_BAR; PG8_WAIT_L(0); PG8_MMA(0, 1, At, B1); PG8_BAR;
            PG8_LDA(At, 0, 1); PG8_STAGE(PG8_SA(0, 0), a2, voffA);
            PG8_BAR; PG8_WAIT_L(0); PG8_MMA(1, 0, At, B0); PG8_BAR; PG8_SCHED;
            PG8_STAGE(PG8_SB(0, 1), b2 + hstep, voffB);
            PG8_WAIT_V(6); PG8_BAR; PG8_MMA(1, 1, At, B1); PG8_BAR;
            PG8_LDB(B0, 1, 0); PG8_SCHED; PG8_LDA(At, 1, 0); PG8_STAGE(PG8_SA(0, 1), a2 + hstep, voffA);
            PG8_WAIT_L(8); PG8_BAR; PG8_WAIT_L(0); PG8_MMA(0, 0, At, B0); PG8_BAR; PG8_SCHED;
            PG8_LDB(B1, 1, 1); PG8_STAGE(PG8_SB(1, 0), b3, voffB);
            PG8_BAR; PG8_WAIT_L(0); PG8_MMA(0, 1, At, B1); PG8_BAR;
            PG8_LDA(At, 1, 1); PG8_STAGE(PG8_SA(1, 0), a3, voffA);
            PG8_BAR; PG8_WAIT_L(0); PG8_MMA(1, 0, At, B0); PG8_BAR; PG8_SCHED;
            PG8_STAGE(PG8_SB(1, 1), b3 + hstep, voffB);
            PG8_WAIT_V(6); PG8_BAR; PG8_MMA(1, 1, At, B1); PG8_BAR;
            }
        }
        if constexpr (ALIGN_EPI) { if (wr == 0) PG8_BAR; }
        if constexpr (!Epi::AFTER_DRAIN) { E(acc, cur, wr, wc, fr, fq); S.done(cur); }
        if (!has_next) break;
#pragma unroll
        for (int a = 0; a < 2; ++a)
#pragma unroll
            for (int b = 0; b < 2; ++b)
#pragma unroll
                for (int m = 0; m < 4; ++m)
#pragma unroll
                    for (int n = 0; n < 2; ++n) acc[a][b][m][n] = (f32x4){0.f, 0.f, 0.f, 0.f};
        cur = nxt; cA = nA; cB = nB; ++ui;
        if constexpr (ALIGN_EPI) { if (wr == 1) PG8_BAR; }
    }
    PG8_WAIT_V(0);
    if constexpr (!ALIGN_EPI) { if (wr == 0) PG8_BAR; }
    PG8_BAR;
    if constexpr (Epi::AFTER_DRAIN) { E.fused(acc, cur, wr, wc, fr, fq, lds, wid, lane); S.done(cur); }
#undef PG8_SA
#undef PG8_SB
#undef PG8_STAGE
#undef PG8_LDA
#undef PG8_LDB
#undef PG8_MMA
#undef PG8_WAIT_V
#undef PG8_WAIT_L
#undef PG8_BAR
#undef PG8_SCHED
}
}

#define LAS __attribute__((address_space(3)))
typedef unsigned short bf16_t;
typedef short bf16x8 __attribute__((ext_vector_type(8)));
typedef short s16x4 __attribute__((ext_vector_type(4)));
typedef float f32x4 __attribute__((ext_vector_type(4)));
typedef float f32x2v __attribute__((ext_vector_type(2)));
typedef float f32x16 __attribute__((ext_vector_type(16)));
typedef unsigned u32x4 __attribute__((ext_vector_type(4)));
typedef unsigned u32x2 __attribute__((ext_vector_type(2)));
typedef __bf16 bf16x2n __attribute__((ext_vector_type(2)));

constexpr int DM = 1024, MROWS = 40960, PROWS = 8192, HROWS = 20480;
constexpr int NPROJ = 6160, NPROJ_PAD = 6400, FFH = 2816, FFU = 5632, NQKV = 1536;
constexpr int LKEYS = 4352;
constexpr size_t MiB = 1u << 20;
constexpr size_t WS_MOD = 1 * MiB, WS_WIN = 2 * MiB, WS_WOUT = 15 * MiB, WS_WUP0 = 19 * MiB, WS_WUP1 = 30 * MiB, WS_WDN0 = 41 * MiB, WS_WDN1 = 47 * MiB,
                 WS_WQKV = 53 * MiB, WS_WO = 56 * MiB, WS_H = 58 * MiB, WS_BIG = 138 * MiB;
constexpr size_t WS_PROJ = WS_BIG, WS_STATES = 379 * MiB, WS_YG = 379 * MiB, WS_DEC = 500 * MiB, WS_COEF = 501 * MiB, WS_EDGE = 470 * MiB;
constexpr size_t WS_ACT1 = WS_BIG, WS_ACT = 358 * MiB;
constexpr size_t WS_QKV = WS_BIG, WS_KCAT = 258 * MiB, WS_VCAT = 276 * MiB, WS_KP = 294 * MiB, WS_VP = 298 * MiB, WS_O = 302 * MiB;
constexpr size_t WS_NEED = 510 * MiB;
constexpr int LDS_BYTES = 147456;
constexpr size_t OUT_SRET = 41943040, OUT_SSSM = 46137344, OUT_CK = 54525952, OUT_CV = 56623104;

__device__ __forceinline__ unsigned pk2(float lo, float hi) { f32x2v v = {lo, hi}; bf16x2n b = __builtin_convertvector(v, bf16x2n); return __builtin_bit_cast(unsigned, b); }
__device__ __forceinline__ float bflo(unsigned w) { return __builtin_bit_cast(float, w << 16); }
__device__ __forceinline__ float bfhi(unsigned w) { return __builtin_bit_cast(float, w & 0xffff0000u); }
__device__ __forceinline__ float bf2f(bf16_t b) { return __builtin_bit_cast(float, (unsigned)b << 16); }
__device__ __forceinline__ bf16_t f2bf1(float f) { return (bf16_t)(pk2(f, 0.f) & 0xffffu); }
__device__ __forceinline__ float silu_f(float x) { return x * __builtin_amdgcn_rcpf(1.f + __expf(-x)); }
__device__ __forceinline__ int crow(int r, int hi) { return (r & 3) + 8 * (r >> 2) + 4 * hi; }
__device__ __forceinline__ int cond_of(int grow) { return grow < PROWS ? 0 : 1 + ((grow - PROWS) >> 12); }
__device__ __forceinline__ float shx(float v, int o, int lane) { return __builtin_bit_cast(float, __builtin_amdgcn_ds_bpermute((lane ^ o) << 2, __builtin_bit_cast(int, v))); }
__device__ __forceinline__ float shidx(float v, int idx) { return __builtin_bit_cast(float, __builtin_amdgcn_ds_bpermute(idx << 2, __builtin_bit_cast(int, v))); }
__device__ __forceinline__ float wave_sum(float v, int lane) {
#pragma unroll
    for (int o = 1; o < 64; o <<= 1) v += shx(v, o, lane);
    return v;
}
#define UNPACK8(W_, F_) do { F_[0] = bflo((W_).x); F_[1] = bfhi((W_).x); F_[2] = bflo((W_).y); F_[3] = bfhi((W_).y); F_[4] = bflo((W_).z); F_[5] = bfhi((W_).z); F_[6] = bflo((W_).w); F_[7] = bfhi((W_).w); } while (0)

namespace pg8 {
struct EpiStoreBf16 {
    static constexpr bool PERM = true, AFTER_DRAIN = false;
    bf16_t* O; int ldc; int ncols;
    __device__ __forceinline__ void operator()(const f32x4 (&acc)[2][2][4][2], const Unit& u, int wr, int wc, int fr, int fq) const {
        const int row0 = u.pm * BM + wr * 64 + fr; const int col0 = u.pn * BM + wc * 32 + 8 * fq;
#pragma unroll
        for (int ai = 0; ai < 2; ++ai)
#pragma unroll
            for (int m = 0; m < 4; ++m) { bf16_t* rowp = O + (size_t)(row0 + ai * HALF + m * 16) * ldc + col0;
#pragma unroll
                for (int bj = 0; bj < 2; ++bj) { if (col0 + bj * HALF < ncols) { const f32x4 v0 = acc[ai][bj][m][0], v1 = acc[ai][bj][m][1];
                    u32x4 w; w.x = ::pk2(v0[0], v0[1]); w.y = ::pk2(v0[2], v0[3]); w.z = ::pk2(v1[0], v1[1]); w.w = ::pk2(v1[2], v1[3]);
                    *(u32x4*)(rowp + bj * HALF) = w; } } }
    }
};
struct EpiResid {
    static constexpr bool PERM = false, AFTER_DRAIN = false;
    const float* base0; const float* base1; float* out; const float* gate; int row_off;
    __device__ __forceinline__ void operator()(const f32x4 (&acc)[2][2][4][2], const Unit& u, int wr, int wc, int fr, int fq) const {
#pragma unroll
        for (int ai = 0; ai < 2; ++ai)
#pragma unroll
            for (int m = 0; m < 4; ++m) { const int grow = row_off + u.pm * BM + ai * HALF + wr * 64 + m * 16 + fr;
                const int cnd = grow < PROWS ? 0 : 1 + ((grow - PROWS) >> 12);
                const float* bp = grow < PROWS ? base0 + (size_t)grow * DM : base1 + (size_t)(grow - PROWS) * DM;
                const float* gp = gate + cnd * 6144; float* op = out + (size_t)grow * DM;
#pragma unroll
                for (int bj = 0; bj < 2; ++bj)
#pragma unroll
                    for (int n = 0; n < 2; ++n) { const int col = u.pn * BM + bj * HALF + wc * 32 + n * 16 + 4 * fq;
                        const f32x4 b = *(const f32x4*)(bp + col), g = *(const f32x4*)(gp + col);
                        *(f32x4*)(op + col) = b + g * acc[ai][bj][m][n]; } }
    }
};
template <int CTRL> __device__ __forceinline__ float dpp_f(float oldv, float src) { return __builtin_bit_cast(float, __builtin_amdgcn_update_dpp(__builtin_bit_cast(int, oldv), __builtin_bit_cast(int, src), CTRL, 0xf, 0xf, false)); }
#define DPP4(res_, old_, src_, ctrl_) do { (res_)[0] = dpp_f<ctrl_>((old_)[0], (src_)[0]); (res_)[1] = dpp_f<ctrl_>((old_)[1], (src_)[1]); (res_)[2] = dpp_f<ctrl_>((old_)[2], (src_)[2]); (res_)[3] = dpp_f<ctrl_>((old_)[3], (src_)[3]); } while (0)
struct EpiConvFfn {
    static constexpr bool PERM = true, AFTER_DRAIN = false;
    bf16_t* act; float* edge; const float* cw; const float* cb; int grow0; PG8_LAS float* xch;
    __device__ __forceinline__ void operator()(const f32x4 (&acc)[2][2][4][2], const Unit& u, int wr, int wc, int fr, int fq) const {
        asm volatile("" : "+v"(fr), "+v"(fq));
        int chl = wc * 32 + 8 * fq;
        asm volatile("" : "+v"(chl));
        const int grow_t = grow0 + u.pm * BM; const int gt = grow_t >> 8;
        bool seq_first, seq_last; if (grow_t < PROWS) { seq_first = true; seq_last = true; } else { const int pos = (grow_t - PROWS) & 4095; seq_first = pos == 0; seq_last = pos == 4096 - 256; }
#pragma unroll
        for (int ai = 0; ai < 2; ++ai) { const int b = 2 * ai + wr;
#pragma unroll
            for (int bj = 0; bj < 2; ++bj)
#pragma unroll
                for (int n = 0; n < 2; ++n) {
                    if (fr == 0) *(PG8_LAS f32x4*)(xch + (b * 2 + 0) * 256 + bj * 128 + chl + 4 * n) = acc[ai][bj][0][n];
                    if (fr == 15) *(PG8_LAS f32x4*)(xch + (b * 2 + 1) * 256 + bj * 128 + chl + 4 * n) = acc[ai][bj][3][n];
                    if (b == 0 && fr < 2) *(f32x4*)(edge + ((size_t)gt * 4 + fr) * FFU + u.pn * BM + bj * 128 + chl + 4 * n) = acc[ai][bj][0][n];
                    if (b == 3 && fr >= 14) *(f32x4*)(edge + ((size_t)gt * 4 + fr - 12) * FFU + u.pn * BM + bj * 128 + chl + 4 * n) = acc[ai][bj][3][n]; } }
        asm volatile("s_waitcnt lgkmcnt(0)" ::: "memory"); __builtin_amdgcn_s_barrier(); asm volatile("" ::: "memory");
        typedef unsigned u32x2_t __attribute__((ext_vector_type(2)));
#pragma unroll
        for (int n = 0; n < 2; ++n) {
            const int ch = u.pn * 128 + chl + 4 * n;
#pragma unroll
            for (int ai = 0; ai < 2; ++ai) { const int b = 2 * ai + wr;
                f32x4 sg[4];
#pragma unroll
                for (int bj = 0; bj < 2; ++bj) { const int wi = bj * FFH + ch;
                    const f32x4 w0 = *(const f32x4*)(cw + wi), w1 = *(const f32x4*)(cw + FFU + wi), w2 = *(const f32x4*)(cw + 2 * FFU + wi), bb = *(const f32x4*)(cb + wi);
                    f32x4 pv_edge = (f32x4){0.f, 0.f, 0.f, 0.f}, nx_edge = (f32x4){0.f, 0.f, 0.f, 0.f};
                    if (b > 0) pv_edge = *(const PG8_LAS f32x4*)(xch + ((b - 1) * 2 + 1) * 256 + bj * 128 + chl + 4 * n);
                    if (b < 3) nx_edge = *(const PG8_LAS f32x4*)(xch + ((b + 1) * 2 + 0) * 256 + bj * 128 + chl + 4 * n);
#pragma unroll
                    for (int m = 0; m < 4; ++m) { const f32x4 v = acc[ai][bj][m][n];
                        f32x4 fbp, fbn, pv, nx;
                        if (m > 0) { DPP4(fbp, v, acc[ai][bj][m - 1][n], 0x121); } else fbp = pv_edge;
                        if (m < 3) { DPP4(fbn, v, acc[ai][bj][m + 1][n], 0x12F); } else fbn = nx_edge;
                        DPP4(pv, fbp, v, 0x111);
                        DPP4(nx, fbn, v, 0x101);
                        const f32x4 c = w0 * pv + w1 * v + w2 * nx + bb;
                        if (bj == 0) {
#pragma unroll
                            for (int e = 0; e < 4; ++e) sg[m][e] = ::silu_f(c[e]); }
                        else { const f32x4 o = sg[m] * c;
                            const int r = ai * HALF + wr * 64 + m * 16 + fr;
                            const bool skip = (r == 0 && !seq_first) || (r == 255 && !seq_last);
                            if (!skip) *(u32x2_t*)(act + (size_t)(u.pm * BM + r) * FFH + ch) = (u32x2_t){::pk2(o[0], o[1]), ::pk2(o[2], o[3])}; } } }
                asm volatile("" ::: "memory"); }
        }
    }
};
}

template <int KT> __device__ __forceinline__ void mma_tile(f32x16& acc, const LAS bf16_t* A, int lda, const LAS bf16_t* B, int ldb, int lane) {
    const int r = lane & 31, h = lane >> 5;
    const LAS bf16_t* ap = A + r * lda + 8 * h; const LAS bf16_t* bp = B + r * ldb + 8 * h;
#pragma unroll 4
    for (int k = 0; k < KT; k += 16) { const bf16x8 a = *(const LAS bf16x8*)(ap + k); const bf16x8 b = *(const LAS bf16x8*)(bp + k);
        acc = __builtin_amdgcn_mfma_f32_32x32x16_bf16(a, b, acc, 0, 0, 0); }
}

struct KArgs { const float* in[30]; float* out; unsigned char* ws; int lo, hi; };
typedef const __attribute__((address_space(4))) KArgs* KAP;

__device__ __forceinline__ void transpose_item(const float* W, int ldn, int K, int nblk, bf16_t* WT, LAS float* scr, int item, int lane, bool upmap = false) {
    const int kb = item / nblk, nb = item % nblk, k0 = 64 * kb, n0 = 32 * nb;
    int nd = n0;
    if (upmap) { const int isv = n0 >= FFH, c = isv ? n0 - FFH : n0; nd = (c >> 7) * 256 + isv * 128 + (c & 127); }
#pragma unroll 8
    for (int i = 0; i < 32; ++i) { const int kk = 2 * i + (lane >> 5); scr[kk * 33 + (lane & 31)] = W[(size_t)(k0 + kk) * ldn + n0 + (lane & 31)]; }
    asm volatile("s_waitcnt lgkmcnt(0)" ::: "memory");
    const int c = lane & 7;
#pragma unroll
    for (int j = 0; j < 4; ++j) { const int n = (lane >> 3) + 8 * j; const LAS float* s = scr + (8 * c) * 33 + n;
        u32x4 o; o.x = pk2(s[0 * 33], s[1 * 33]); o.y = pk2(s[2 * 33], s[3 * 33]); o.z = pk2(s[4 * 33], s[5 * 33]); o.w = pk2(s[6 * 33], s[7 * 33]);
        *(u32x4*)(WT + (size_t)(nd + n) * K + k0 + 8 * c) = o; }
    asm volatile("s_waitcnt lgkmcnt(0)" ::: "memory");
}

__device__ __forceinline__ void phase_prologue(KAP a, LAS unsigned char* lds, int tid, int lane, int wave, int blk, int nblk) {
    unsigned char* ws = a->ws;
    {
        LAS float* sc = (LAS float*)lds; LAS float* red = sc + 9 * 1024;
        float* MOD = (float*)(ws + WS_MOD);
        for (int unit = blk; unit < 192; unit += nblk) {
            for (int i = tid; i < 9 * 1024; i += 512) { const int c = i >> 10, k = i & 1023; const float v = (c == 0) ? a->in[7][k] : a->in[6][(c - 1) * 1024 + k]; sc[i] = silu_f(v); }
            __syncthreads();
            const int l = unit / 96, j0 = (unit % 96) * 64;
            const float* w = a->in[8] + (size_t)l * 1024 * 6144 + j0 + lane;
            float s0 = 0, s1 = 0, s2 = 0, s3 = 0, s4 = 0, s5 = 0, s6 = 0, s7 = 0, s8 = 0;
#pragma unroll 8
            for (int k = wave * 128; k < wave * 128 + 128; ++k) { const float wv = w[(size_t)k * 6144];
                s0 += sc[k] * wv; s1 += sc[1024 + k] * wv; s2 += sc[2048 + k] * wv; s3 += sc[3072 + k] * wv; s4 += sc[4096 + k] * wv;
                s5 += sc[5120 + k] * wv; s6 += sc[6144 + k] * wv; s7 += sc[7168 + k] * wv; s8 += sc[8192 + k] * wv; }
            LAS float* rp = red + wave * 576 + lane;
            rp[0] = s0; rp[64] = s1; rp[128] = s2; rp[192] = s3; rp[256] = s4; rp[320] = s5; rp[384] = s6; rp[448] = s7; rp[512] = s8;
            __syncthreads();
            for (int i = tid; i < 576; i += 512) { float s = 0.f;
#pragma unroll
                for (int w8 = 0; w8 < 8; ++w8) s += red[w8 * 576 + i];
                const int c = i >> 6, ln = i & 63; MOD[(l * 9 + c) * 6144 + j0 + ln] = s + a->in[9][l * 6144 + j0 + ln]; }
            __syncthreads();
        }
    }
    __syncthreads();
    {
        LAS float* scr = (LAS float*)(lds + wave * 16384);
        const int gw = blk * 8 + wave, NGW = nblk * 8;
        constexpr int I_IN = 16 * 192, I_OUT = 32 * 32, I_UP = 16 * 176, I_DN = 44 * 32, I_QKV = 16 * 48, I_WO = 16 * 32;
        constexpr int NITEMS = I_IN + I_OUT + 2 * I_UP + 2 * I_DN + I_QKV + I_WO;
        for (int it = gw; it < NITEMS; it += NGW) {
            int r = it;
            if (r < I_IN) { transpose_item(a->in[16], NPROJ, 1024, 192, (bf16_t*)(ws + WS_WIN), scr, r, lane); continue; } r -= I_IN;
            if (r < I_OUT) { transpose_item(a->in[17], 1024, 2048, 32, (bf16_t*)(ws + WS_WOUT), scr, r, lane); continue; } r -= I_OUT;
            if (r < I_UP) { transpose_item(a->in[12], FFU, 1024, 176, (bf16_t*)(ws + WS_WUP0), scr, r, lane, true); continue; } r -= I_UP;
            if (r < I_UP) { transpose_item(a->in[12] + (size_t)1024 * FFU, FFU, 1024, 176, (bf16_t*)(ws + WS_WUP1), scr, r, lane, true); continue; } r -= I_UP;
            if (r < I_DN) { transpose_item(a->in[15], 1024, FFH, 32, (bf16_t*)(ws + WS_WDN0), scr, r, lane); continue; } r -= I_DN;
            if (r < I_DN) { transpose_item(a->in[15] + (size_t)FFH * 1024, 1024, FFH, 32, (bf16_t*)(ws + WS_WDN1), scr, r, lane); continue; } r -= I_DN;
            if (r < I_QKV) { transpose_item(a->in[26], NQKV, 1024, 48, (bf16_t*)(ws + WS_WQKV), scr, r, lane); continue; } r -= I_QKV;
            transpose_item(a->in[29], 1024, 1024, 32, (bf16_t*)(ws + WS_WO), scr, r, lane);
        }
        bf16_t* WIN = (bf16_t*)(ws + WS_WIN);
        for (int i = blk * 512 + tid; i < 256 * 1024; i += nblk * 512) { const int n = i >> 10, k = i & 1023;
            WIN[(size_t)(6144 + n) * 1024 + k] = (n < 16) ? f2bf1(a->in[16][(size_t)k * NPROJ + 6144 + n]) : (bf16_t)0; }
    }
}

__device__ __forceinline__ void phase_norm(const float* x0, const float* x1, const float* nw, const float* mod_l, int sh_off, int sc_off,
                                           int row0, int nrows, bf16_t* dst, float* xcopy, int lane, int wave, int blk, int nblk) {
    for (int rr = blk * 8 + wave; rr < nrows; rr += nblk * 8) {
        const int grow = row0 + rr; const int cnd = cond_of(grow);
        const float* xrow = grow < PROWS ? x0 + (size_t)grow * DM : x1 + (size_t)(grow - PROWS) * DM;
        const f32x4* xr = (const f32x4*)xrow + lane;
        f32x4 v[4]; float s = 0.f;
#pragma unroll
        for (int j = 0; j < 4; ++j) { v[j] = xr[64 * j]; s += (v[j].x * v[j].x + v[j].y * v[j].y) + (v[j].z * v[j].z + v[j].w * v[j].w); }
        if (xcopy) { f32x4* xo = (f32x4*)(xcopy + (size_t)grow * DM) + lane;
#pragma unroll
            for (int j = 0; j < 4; ++j) xo[64 * j] = v[j]; }
        const float rstd = 1.0f / sqrtf(wave_sum(s, lane) * (1.f / DM) + 1e-6f);
        const float* mp = mod_l + cnd * 6144;
        unsigned long long* o8 = (unsigned long long*)(dst + (size_t)rr * DM) + lane;
#pragma unroll
        for (int j = 0; j < 4; ++j) { const int col = 256 * j + 4 * lane;
            const f32x4 w = *(const f32x4*)(nw + col), sc = *(const f32x4*)(mp + sc_off + col), sh = *(const f32x4*)(mp + sh_off + col);
            const f32x4 h = v[j] * rstd * w * (sc + 1.0f) + sh;
            o8[64 * j] = (unsigned long long)pk2(h.x, h.y) | ((unsigned long long)pk2(h.z, h.w) << 32); }
    }
}

__device__ __forceinline__ void seq_pos(int grow, int& pos, int& len) { if (grow < PROWS) { pos = grow & 255; len = 256; } else { pos = (grow - PROWS) & 4095; len = 4096; } }

__device__ __forceinline__ void phase_conv_xbc(const bf16_t* proj, bf16_t* xbc, const float* cw, const float* cb, int grow0, int tid, int blk, int nblk) {
    const int nitems = (HROWS / 8) * 256;
    for (int it = blk * 512 + tid; it < nitems; it += nblk * 512) {
        const int cg8 = it & 255, run = it >> 8, c = cg8 * 8, r0 = run * 8;
        int pos, len; seq_pos(grow0 + r0, pos, len);
        const bf16_t* src = proj + (size_t)r0 * NPROJ + 4096 + c;
        u32x4 w[10];
#pragma unroll
        for (int i = 0; i < 10; ++i) { const bool ok = (i == 0) ? (pos > 0) : (i == 9 ? (pos + 8 < len) : true);
            const u32x4 t_ = *(const u32x4*)(src + (ptrdiff_t)(ok ? i - 1 : 0) * NPROJ); w[i].x = ok ? t_.x : 0u; w[i].y = ok ? t_.y : 0u; w[i].z = ok ? t_.z : 0u; w[i].w = ok ? t_.w : 0u; }
        float w0[8], w1[8], w2[8], bb[8];
#pragma unroll
        for (int e = 0; e < 8; e += 4) { const f32x4 a0 = *(const f32x4*)(cw + c + e), a1 = *(const f32x4*)(cw + 2048 + c + e), a2 = *(const f32x4*)(cw + 4096 + c + e), a3 = *(const f32x4*)(cb + c + e);
#pragma unroll
            for (int k = 0; k < 4; ++k) { w0[e + k] = a0[k]; w1[e + k] = a1[k]; w2[e + k] = a2[k]; bb[e + k] = a3[k]; } }
        float p[8], q[8], n[8];
        UNPACK8(w[0], p); UNPACK8(w[1], q);
#pragma unroll
        for (int i = 0; i < 8; ++i) {
            UNPACK8(w[i + 2], n);
            float o[8];
#pragma unroll
            for (int e = 0; e < 8; ++e) { o[e] = silu_f(p[e] * w0[e] + q[e] * w1[e] + n[e] * w2[e] + bb[e]); p[e] = q[e]; q[e] = n[e]; }
            u32x4 ww; ww.x = pk2(o[0], o[1]); ww.y = pk2(o[2], o[3]); ww.z = pk2(o[4], o[5]); ww.w = pk2(o[6], o[7]);
            *(u32x4*)(xbc + (size_t)(r0 + i) * 2048 + c) = ww;
        }
    }
}

constexpr int FFQ = 1408;
__device__ __forceinline__ void ffn_seam_fixup(const float* edge, bf16_t* act_tile, const float* cw, const float* cb, int gt, int tid) {
    const int grow_t = gt * 256; if (grow_t < PROWS) return;
    const int pos = (grow_t - PROWS) & 4095; const bool first = pos == 0, last = pos == 4096 - 256;
    for (int i = tid; i < 2 * FFH; i += 512) { const int which = i >= FFH, ch = which ? i - FFH : i;
        if ((which == 0 && first) || (which == 1 && last)) continue;
        const int ca = (ch >> 7) * 256 + (ch & 127), cvv = ca + 128;
        const float* e0; const float* e1; const float* e2;
        if (which == 0) { e0 = edge + ((size_t)(gt - 1) * 4 + 3) * FFU; e1 = edge + ((size_t)gt * 4 + 0) * FFU; e2 = edge + ((size_t)gt * 4 + 1) * FFU; }
        else { e0 = edge + ((size_t)gt * 4 + 2) * FFU; e1 = edge + ((size_t)gt * 4 + 3) * FFU; e2 = edge + ((size_t)(gt + 1) * 4 + 0) * FFU; }
        const float av = cw[ch] * e0[ca] + cw[FFU + ch] * e1[ca] + cw[2 * FFU + ch] * e2[ca] + cb[ch];
        const float vv = cw[FFH + ch] * e0[cvv] + cw[FFU + FFH + ch] * e1[cvv] + cw[2 * FFU + FFH + ch] * e2[cvv] + cb[FFH + ch];
        act_tile[(size_t)(which ? 255 : 0) * FFH + ch] = f2bf1(silu_f(av) * vv); }
}

#define XB_TMO      128
#define XB_XCNT(j)  (256  + 64 * (j))
#define XB_XSUB(j)  (1280 + 64 * (j))
#define XB_XGEN(j)  (2304 + 64 * (j))
#define XB_TOP      3328
#define XB_TOPGEN   3392
#define XCD_BAR_WORDS 3456
#define XB_SPIN_CAP (1u << 18)

__device__ __forceinline__ unsigned xb_ld(unsigned* p)              { return __hip_atomic_load(p, __ATOMIC_RELAXED, __HIP_MEMORY_SCOPE_AGENT); }
__device__ __forceinline__ unsigned xb_add(unsigned* p, unsigned v) { return __hip_atomic_fetch_add(p, v, __ATOMIC_RELAXED, __HIP_MEMORY_SCOPE_AGENT); }
__device__ __forceinline__ unsigned xb_xcc_id() { return (unsigned)__builtin_amdgcn_s_getreg((3 << 11) | 20) & 0xFu; }
#define XB_SPIN(cond, bar) do { unsigned _sp = 0; while (cond) { __builtin_amdgcn_s_sleep(1); \
    if ((++_sp & 255u) == 0u) { if (xb_ld(&(bar)[XB_TMO])) break; if (_sp > XB_SPIN_CAP) { atomicAdd(&(bar)[XB_TMO], 1u); break; } } } } while (0)

struct XcdBarrier {
    unsigned* bar; unsigned x;
    volatile LAS unsigned* st;
};

__device__ __forceinline__ XcdBarrier xcd_barrier_post(unsigned* bar, volatile LAS unsigned* st) {
    XcdBarrier b; b.bar = bar; b.x = xb_xcc_id(); b.st = st;
    if (threadIdx.x == 0) (void)xb_add(&bar[XB_XCNT(b.x)], 1u);
    return b;
}
__device__ __forceinline__ void xcd_barrier_complete(unsigned* bar, unsigned x, unsigned& nloc, unsigned& nx) {
    const unsigned G = gridDim.x * gridDim.y * gridDim.z;
    unsigned sum, cnt, mine, sp = 0u;
    for (;;) {
        sum = 0u; cnt = 0u; mine = 0u;
#pragma unroll
        for (unsigned j = 0; j < 16; ++j) { const unsigned c = xb_ld(&bar[XB_XCNT(j)]); sum += c; cnt += (c > 0u) ? 1u : 0u; mine = (j == x) ? c : mine; }
        if (sum == G) break;
        __builtin_amdgcn_s_sleep(1);
        if ((++sp & 255u) == 0u) { if (xb_ld(&bar[XB_TMO])) break; if (sp > XB_SPIN_CAP) { atomicAdd(&bar[XB_TMO], 1u); break; } }
    }
    nloc = mine > 0u ? mine : 1u; nx = cnt > 0u ? cnt : 1u;
}

__device__ __forceinline__ void xcd_barrier(const XcdBarrier& b) {
    asm volatile("s_waitcnt vmcnt(0)" ::: "memory");
    __syncthreads();
    if (threadIdx.x == 0) {
        unsigned* bar = b.bar;
        __builtin_amdgcn_s_waitcnt(0);
        unsigned nloc = b.st[0], nx = b.st[1];
        if (nloc == 0u) { xcd_barrier_complete(bar, b.x, nloc, nx); b.st[0] = nloc; b.st[1] = nx; }
        const unsigned old = xb_add(&bar[XB_XSUB(b.x)], 1u);
        const unsigned gen = old / nloc;
        if (old + 1u == (gen + 1u) * nloc) {
            __builtin_amdgcn_fence(__ATOMIC_RELEASE, "agent");
            asm volatile("s_waitcnt vmcnt(0)" ::: "memory");
            const unsigned og = xb_add(&bar[XB_TOP], 1u);
            const unsigned tg = og / nx;
            if (og + 1u == (tg + 1u) * nx) xb_add(&bar[XB_TOPGEN], 1u);
            else XB_SPIN(xb_ld(&bar[XB_TOPGEN]) == tg, bar);
            __builtin_amdgcn_fence(__ATOMIC_ACQUIRE, "agent");
            xb_add(&bar[XB_XGEN(b.x)], 1u);
            asm volatile("s_waitcnt vmcnt(0)" ::: "memory");
        } else {
            XB_SPIN(xb_ld(&bar[XB_XGEN(b.x)]) == gen, bar);
            __builtin_amdgcn_fence(__ATOMIC_ACQUIRE, "agent");
            asm volatile("s_waitcnt vmcnt(0)" ::: "memory");
        }
    }
    __syncthreads();
}


constexpr int LDS_COEF = 139264;
__device__ __forceinline__ float softplus_f(float x) { const float e = __expf(-fabsf(x)); const float l = (e < 1e-3f) ? e * (1.f - 0.5f * e) : __logf(1.f + e); return fmaxf(x, 0.f) + l; }
__device__ __forceinline__ void chunk_coeffs(float* cf, KAP a, int u, const bf16_t* projrow, int lane) {
    float lf0, lf1, lb0, lb1, df0, df1, db0, db1;
    if (u < 8) { const float lf = a->in[18][u], lb = a->in[18][8 + u]; lf0 = lf1 = lf; lb0 = lb1 = lb; df0 = df1 = db0 = db1 = 1.f; }
    else { const int hd = u - 8; const float Af = __expf(a->in[22][hd]), Ab = __expf(a->in[22][16 + hd]), bf = a->in[23][hd], bb = a->in[23][16 + hd];
        const float r0 = bf2f(projrow[(size_t)(2 * lane) * NPROJ + 6144 + hd]), r1 = bf2f(projrow[(size_t)(2 * lane + 1) * NPROJ + 6144 + hd]);
        df0 = softplus_f(r0 + bf); df1 = softplus_f(r1 + bf); db0 = softplus_f(r0 + bb); db1 = softplus_f(r1 + bb);
        lf0 = -df0 * Af; lf1 = -df1 * Af; lb0 = -db0 * Ab; lb1 = -db1 * Ab; }
    float pf = lf0 + lf1, pb = lb0 + lb1;
#pragma unroll
    for (int o = 1; o < 64; o <<= 1) { const float tf = shidx(pf, (lane - o) & 63), tb = shidx(pb, (lane - o) & 63); if (lane >= o) { pf += tf; pb += tb; } }
    const float totb = shidx(pb, 63);
    *(f32x2v*)(cf + 2 * lane) = (f32x2v){pf - lf1, pf};
    *(f32x2v*)(cf + 128 + 2 * lane) = (f32x2v){totb - (pb - lb1) + lb0, totb - pb + lb1};
    *(f32x2v*)(cf + 256 + 2 * lane) = (f32x2v){df0, df1}; *(f32x2v*)(cf + 384 + 2 * lane) = (f32x2v){db0, db1};
}
__device__ __forceinline__ void phase_coeffs(KAP a, int lane, int wave, int blk, int nblk) {
    const bf16_t* proj = (const bf16_t*)(a->ws + WS_PROJ); float* coef = (float*)(a->ws + WS_COEF);
    for (int task = blk * 8 + wave; task < 160 * 24; task += nblk * 8) { const int cl = task / 24, u = task % 24;
        chunk_coeffs(coef + (size_t)task * 512, a, u, proj + (size_t)cl * 128 * NPROJ, lane); }
}

#define TR_STORE8(dst_, w_) do { (dst_)[0] = (bf16_t)((w_).x & 0xffff); (dst_)[136] = (bf16_t)((w_).x >> 16); (dst_)[272] = (bf16_t)((w_).y & 0xffff); (dst_)[408] = (bf16_t)((w_).y >> 16); \
        (dst_)[544] = (bf16_t)((w_).z & 0xffff); (dst_)[680] = (bf16_t)((w_).z >> 16); (dst_)[816] = (bf16_t)((w_).w & 0xffff); (dst_)[952] = (bf16_t)((w_).w >> 16); } while (0)


typedef short v4i16_t __attribute__((ext_vector_type(4)));
__device__ __forceinline__ bf16x8 tr_frag(const LAS bf16_t* p, int ld4) {
    const v4i16_t lo = __builtin_amdgcn_ds_read_tr16_b64_v4i16((LAS v4i16_t*)p), hh = __builtin_amdgcn_ds_read_tr16_b64_v4i16((LAS v4i16_t*)(p + ld4));
    return (bf16x8){lo[0], lo[1], lo[2], lo[3], hh[0], hh[1], hh[2], hh[3]};
}
__device__ __forceinline__ const LAS bf16_t* tr_base(const LAS bf16_t* M, int ld, int c0, int lane) {
    return M + (8 * (lane >> 5) + ((lane & 15) >> 2)) * ld + c0 + 16 * ((lane >> 4) & 1) + 4 * (lane & 3);
}
template <int KT> __device__ __forceinline__ void mma_tile_tt(f32x16& acc, const LAS bf16_t* MA, int lda, int a0, const LAS bf16_t* MB, int ldb, int b0, int lane) {
    const LAS bf16_t* ap = tr_base(MA, lda, a0, lane); const LAS bf16_t* bp = tr_base(MB, ldb, b0, lane);
#pragma unroll 4
    for (int k = 0; k < KT; k += 16) { const bf16x8 a = tr_frag(ap + k * lda, 4 * lda), b = tr_frag(bp + k * ldb, 4 * ldb);
        acc = __builtin_amdgcn_mfma_f32_32x32x16_bf16(a, b, acc, 0, 0, 0); }
}
template <int KT> __device__ __forceinline__ void mma_tile_nt(f32x16& acc, const LAS bf16_t* A, int lda, const LAS bf16_t* MB, int ldb, int b0, int lane) {
    const LAS bf16_t* ap = A + (lane & 31) * lda + 8 * (lane >> 5); const LAS bf16_t* bp = tr_base(MB, ldb, b0, lane);
#pragma unroll 4
    for (int k = 0; k < KT; k += 16) { const bf16x8 a = *(const LAS bf16x8*)(ap + k); const bf16x8 b = tr_frag(bp + k * ldb, 4 * ldb);
        acc = __builtin_amdgcn_mfma_f32_32x32x16_bf16(a, b, acc, 0, 0, 0); }
}

template <int DK, int DV> struct P1Regs { u32x4 k[DK / 32]; u32x4 v[DV / 32]; float cfj[DK / 32], cbj[DK / 32], dfj[DK / 32], dbj[DK / 32], cl, cb0; };
template <int DK, int DV>
__device__ __forceinline__ void pass1_load(P1Regs<DK, DV>& R, const bf16_t* ksrc, int kld, const bf16_t* vsrc, int vld, const float* cf, int tid) {
#pragma unroll
    for (int it = 0; it < DK / 32; ++it) { const int g = tid + 512 * it, cgp = g % (DK / 8), j = g / (DK / 8);
        R.k[it] = *(const u32x4*)(ksrc + (size_t)j * kld + cgp * 8); R.cfj[it] = cf[j]; R.cbj[it] = cf[128 + j]; R.dfj[it] = cf[256 + j]; R.dbj[it] = cf[384 + j]; }
#pragma unroll
    for (int it = 0; it < DV / 32; ++it) { const int g = tid + 512 * it, cgp = g % (DV / 8), j = g / (DV / 8); R.v[it] = *(const u32x4*)(vsrc + (size_t)j * vld + cgp * 8); }
    R.cl = cf[127]; R.cb0 = cf[128];
}
template <int DK, int DV>
__device__ __forceinline__ void pass1_compute(const P1Regs<DK, DV>& R, LAS unsigned char* lds, float kscale, bf16_t* st_item, float* dec_item, int tid, int lane, int wave) {
    constexpr int LDV = (DV == 128) ? 160 : 96, LDK = 2 * DK + 32;
    LAS bf16_t* V = (LAS bf16_t*)lds; LAS bf16_t* KS = (LAS bf16_t*)(lds + 40960);
#pragma unroll
    for (int it = 0; it < DV / 32; ++it) { const int g = tid + 512 * it, cgp = g % (DV / 8), j = g / (DV / 8); *(LAS u32x4*)(V + j * LDV + cgp * 8) = R.v[it]; }
#pragma unroll
    for (int it = 0; it < DK / 32; ++it) { const int g = tid + 512 * it, cgp = g % (DK / 8), j = g / (DK / 8);
        const float wf = __expf(R.cl - R.cfj[it]) * R.dfj[it] * kscale, wb = __expf(R.cb0 - R.cbj[it]) * R.dbj[it] * kscale;
        float f[8]; UNPACK8(R.k[it], f);
        u32x4 a, b; a.x = pk2(f[0] * wf, f[1] * wf); a.y = pk2(f[2] * wf, f[3] * wf); a.z = pk2(f[4] * wf, f[5] * wf); a.w = pk2(f[6] * wf, f[7] * wf);
        b.x = pk2(f[0] * wb, f[1] * wb); b.y = pk2(f[2] * wb, f[3] * wb); b.z = pk2(f[4] * wb, f[5] * wb); b.w = pk2(f[6] * wb, f[7] * wb);
        *(LAS u32x4*)(KS + j * LDK + cgp * 8) = a; *(LAS u32x4*)(KS + j * LDK + DK + cgp * 8) = b; }
    if (tid == 0) { dec_item[0] = __expf(R.cl); dec_item[1] = __expf(R.cb0); }
}
template <int DK, int DV>
__device__ __forceinline__ void pass1_mma(LAS unsigned char* lds, bf16_t* st_item, int lane, int wave) {
    constexpr int LDV = (DV == 128) ? 160 : 96, LDK = 2 * DK + 32;
    LAS bf16_t* V = (LAS bf16_t*)lds; LAS bf16_t* KS = (LAS bf16_t*)(lds + 40960);
    constexpr int NTN = 2 * DK / 32;
#pragma unroll
    for (int q = 0; q < 2; ++q) { const int id = 2 * wave + q, mt = id / NTN, nt = id % NTN;
        f32x16 acc = {}; mma_tile_tt<128>(acc, V, LDV, 32 * mt, KS, LDK, 32 * nt, lane);
        const int hi = lane >> 5, dcol = 32 * nt + (lane & 31);
#pragma unroll
        for (int r = 0; r < 16; ++r) st_item[(size_t)(32 * mt + crow(r, hi)) * (2 * DK) + dcol] = f2bf1(acc[r]); }
}
template <int DK, int DV, bool RET>
__device__ __forceinline__ void pass1_run(KAP a, LAS unsigned char* lds, int tid, int lane, int wave, int blk, int nblk) {
    const bf16_t* proj = (const bf16_t*)(a->ws + WS_PROJ); const bf16_t* xbc = (const bf16_t*)(a->ws + WS_H); bf16_t* states = (bf16_t*)(a->ws + WS_STATES);
    float* dec = (float*)(a->ws + WS_DEC); const float* coef = (const float*)(a->ws + WS_COEF);
    constexpr int NU = RET ? 8 : 16, U0 = RET ? 0 : 8; const int total = 160 * NU;
    P1Regs<DK, DV> R;
#define P1_SRC(q_) const int cl_ = (q_) / NU, uu_ = (q_) % NU, it_ = cl_ * 24 + U0 + uu_; const size_t r0_ = (size_t)cl_ * 128; \
        const bf16_t* ks_ = RET ? proj + r0_ * NPROJ + 512 + uu_ * 64 : xbc + r0_ * 2048 + 1024 + (uu_ >> 2) * 128; const int kl_ = RET ? NPROJ : 2048; \
        const bf16_t* vs_ = RET ? proj + r0_ * NPROJ + 1024 + uu_ * 128 : xbc + r0_ * 2048 + uu_ * 64;
    int q = (nblk % 8 == 0) ? (blk % 8) * (nblk / 8) + blk / 8 : blk;
    if (q < total) { P1_SRC(q); pass1_load<DK, DV>(R, ks_, kl_, vs_, kl_, coef + (size_t)it_ * 512, tid); }
    for (; q < total; q += nblk) {
        const int cl = q / NU, uu = q % NU, it = cl * 24 + U0 + uu;
        __syncthreads();
        pass1_compute<DK, DV>(R, lds, RET ? 0.125f : 1.f, states + (size_t)it * 16384, dec + it * 2, tid, lane, wave);
        if (q + nblk < total) { P1_SRC(q + nblk); pass1_load<DK, DV>(R, ks_, kl_, vs_, kl_, coef + (size_t)it_ * 512, tid); }
        __syncthreads();
        pass1_mma<DK, DV>(lds, states + (size_t)it * 16384, lane, wave);
    }
    __syncthreads();
#undef P1_SRC
}
__device__ __forceinline__ void phase_pass1(KAP a, LAS unsigned char* lds, int tid, int lane, int wave, int blk, int nblk) {
    pass1_run<64, 128, true>(a, lds, tid, lane, wave, blk, nblk);
    pass1_run<128, 64, false>(a, lds, tid, lane, wave, blk, nblk);
}

template <int DK, int DV> struct P3Regs { u32x4 q[DK / 32]; u32x4 k[DK / 32]; u32x4 v[DV / 32]; u32x4 s[DV * 2 * DK / 4096]; f32x4 c; };
template <int DK, int DV>
__device__ __forceinline__ void pass3_load(P3Regs<DK, DV>& R, const bf16_t* qsrc, const bf16_t* ksrc, int kld, const bf16_t* vsrc, int vld, const bf16_t* st_item, const float* cf, int tid) {
    constexpr int NCG = DK / 8;
#pragma unroll
    for (int it = 0; it < DK / 32; ++it) { const int g = tid + 512 * it, cgp = g % NCG, j = g / NCG;
        R.q[it] = *(const u32x4*)(qsrc + (size_t)j * kld + cgp * 8); R.k[it] = *(const u32x4*)(ksrc + (size_t)j * kld + cgp * 8); }
#pragma unroll
    for (int it = 0; it < DV / 32; ++it) { const int g = tid + 512 * it, cgp = g % (DV / 8), j = g / (DV / 8); R.v[it] = *(const u32x4*)(vsrc + (size_t)j * vld + cgp * 8); }
#pragma unroll
    for (int it = 0; it < DV * 2 * DK / 4096; ++it) R.s[it] = *(const u32x4*)(st_item + (size_t)(tid + 512 * it) * 8);
    if (tid < 128) R.c = *(const f32x4*)(cf + tid * 4);
}
template <int DK, int DV>
__device__ __forceinline__ void pass3_stage(const P3Regs<DK, DV>& R, LAS unsigned char* lds, int tid) {
    constexpr int LQ = DK + 8, LS = 2 * DK + 8, NCG = DK / 8, NCS = 2 * DK / 8, LDV = (DV == 128) ? 160 : 96;
    constexpr int OKP = 128 * LQ * 2, OV = OKP + 34816, OST = OV + 128 * LDV * 2, OCF = 129024;
    LAS bf16_t* Q = (LAS bf16_t*)lds; LAS bf16_t* KP = (LAS bf16_t*)(lds + OKP); LAS bf16_t* V = (LAS bf16_t*)(lds + OV); LAS bf16_t* ST = (LAS bf16_t*)(lds + OST);
    LAS float* cf = (LAS float*)(lds + OCF);
#pragma unroll
    for (int it = 0; it < DK / 32; ++it) { const int g = tid + 512 * it, cgp = g % NCG, j = g / NCG;
        *(LAS u32x4*)(Q + j * LQ + cgp * 8) = R.q[it]; *(LAS u32x4*)(KP + j * LQ + cgp * 8) = R.k[it]; }
#pragma unroll
    for (int it = 0; it < DV / 32; ++it) { const int g = tid + 512 * it, cgp = g % (DV / 8), j = g / (DV / 8); *(LAS u32x4*)(V + j * LDV + cgp * 8) = R.v[it]; }
#pragma unroll
    for (int it = 0; it < DV * 2 * DK / 4096; ++it) { const int g = tid + 512 * it, cgp = g % NCS, vv = g / NCS; *(LAS u32x4*)(ST + vv * LS + cgp * 8) = R.s[it]; }
    if (tid < 128) *(LAS f32x4*)(cf + tid * 4) = R.c;
}
template <int DK, int DV>
__device__ __forceinline__ void pass3_compute(LAS unsigned char* lds, float kscale, float dsum, bf16_t* y0, bf16_t* y1, int yld, int lane, int wave, bool prefetch_sync) {
    constexpr int LQ = DK + 8, LS = 2 * DK + 8, LDV = (DV == 128) ? 160 : 96;
    constexpr int OKP = 128 * LQ * 2, OV = OKP + 34816, OST = OV + 128 * LDV * 2, OCF = 129024;
    LAS bf16_t* Q = (LAS bf16_t*)lds; LAS bf16_t* KP = (LAS bf16_t*)(lds + OKP); LAS bf16_t* V = (LAS bf16_t*)(lds + OV); LAS bf16_t* ST = (LAS bf16_t*)(lds + OST);
    LAS float* cf = (LAS float*)(lds + OCF);
    const int rb = wave >> 1, ch = wave & 1, hi = lane >> 5, l31 = lane & 31;
    f32x16 sc0 = {}, sc1 = {};
    mma_tile<DK>(sc0, Q + rb * 32 * LQ, LQ, KP + (64 * ch) * LQ, LQ, lane);
    mma_tile<DK>(sc1, Q + rb * 32 * LQ, LQ, KP + (64 * ch + 32) * LQ, LQ, lane);
    __syncthreads();
    {
        const int j0 = 64 * ch + l31, j1 = j0 + 32;
        const float cfj0 = cf[j0], cbj0 = cf[128 + j0], dfj0 = cf[256 + j0] * kscale, dbj0 = cf[384 + j0] * kscale;
        const float cfj1 = cf[j1], cbj1 = cf[128 + j1], dfj1 = cf[256 + j1] * kscale, dbj1 = cf[384 + j1] * kscale;
        const bool F0 = rb >= 2 * ch, B0 = rb <= 2 * ch, F1 = rb >= 2 * ch + 1, B1 = rb <= 2 * ch + 1;
#pragma unroll
        for (int r = 0; r < 16; ++r) { const int i = 32 * rb + crow(r, hi); const float cfi = cf[i], cbi = cf[128 + i];
            float f0 = 0.f, f1 = 0.f;
            if (F0) f0 = (i >= j0 ? __expf(fminf(cfi - cfj0, 0.f)) * dfj0 : 0.f);
            if (B0) f0 += (j0 >= i ? __expf(fminf(cbi - cbj0, 0.f)) * dbj0 : 0.f);
            if (F1) f1 = (i >= j1 ? __expf(fminf(cfi - cfj1, 0.f)) * dfj1 : 0.f);
            if (B1) f1 += (j1 >= i ? __expf(fminf(cbi - cbj1, 0.f)) * dbj1 : 0.f);
            KP[i * 136 + j0] = f2bf1(sc0[r] * f0); KP[i * 136 + j1] = f2bf1(sc1[r] * f1); }
    }
    __syncthreads();
#pragma nounroll
    for (int t = 0; t < DV / 64; ++t) { const int colbase = ch * (DV / 2) + 32 * t;
        f32x16 aP = {}, aF = {}, aB = {};
        mma_tile_nt<128>(aP, KP + rb * 32 * 136, 136, V, LDV, colbase, lane);
        __builtin_amdgcn_sched_barrier(0);
        mma_tile<DK>(aF, Q + rb * 32 * LQ, LQ, ST + colbase * LS, LS, lane);
        __builtin_amdgcn_sched_barrier(0);
        mma_tile<DK>(aB, Q + rb * 32 * LQ, LQ, ST + colbase * LS + DK, LS, lane);
        __builtin_amdgcn_sched_barrier(0);
        const int vv = colbase + l31;
        bf16_t* yp = (vv < 64) ? y0 + vv : y1 + (vv - 64);
#pragma unroll
        for (int r = 0; r < 16; ++r) { const int i = 32 * rb + crow(r, hi);
            float y = aP[r] + __expf(cf[i]) * aF[r] + __expf(cf[128 + i]) * aB[r];
            if (dsum != 0.f) y += dsum * bf2f(V[i * LDV + vv]);
            yp[(size_t)i * yld] = f2bf1(y); } }
}
template <int DK, int DV, bool RET>
__device__ __forceinline__ void pass3_run(KAP a, LAS unsigned char* lds, int tid, int lane, int wave, int blk, int nblk, bool dummy) {
    bf16_t* proj = (bf16_t*)(a->ws + WS_PROJ); bf16_t* xbc = (bf16_t*)(a->ws + WS_H); const bf16_t* states = (const bf16_t*)(a->ws + WS_STATES);
    const float* coef = (const float*)(a->ws + WS_COEF);
    constexpr int NU = RET ? 8 : 16, U0 = RET ? 0 : 8; const int total = 160 * NU;
    P3Regs<DK, DV> R;
#define P3_SRC(q_) const int cl_ = (q_) / NU, uu_ = (q_) % NU, it_ = cl_ * 24 + U0 + uu_; const size_t r0_ = (size_t)cl_ * 128; \
        bf16_t* qs_ = RET ? proj + r0_ * NPROJ + uu_ * 64 : xbc + r0_ * 2048 + 1536 + (uu_ >> 2) * 128; \
        bf16_t* ks_ = RET ? proj + r0_ * NPROJ + 512 + uu_ * 64 : xbc + r0_ * 2048 + 1024 + (uu_ >> 2) * 128; const int kl_ = RET ? NPROJ : 2048; \
        bf16_t* vs_ = RET ? proj + r0_ * NPROJ + 1024 + uu_ * 128 : xbc + r0_ * 2048 + uu_ * 64;
    int q = (nblk % 8 == 0) ? (blk % 8) * (nblk / 8) + blk / 8 : blk;
    if (q < total) { P3_SRC(q); pass3_load<DK, DV>(R, qs_, ks_, kl_, vs_, kl_, states + (size_t)it_ * 16384, coef + (size_t)it_ * 512, tid); }
    for (; q < total; q += nblk) {
        P3_SRC(q);
        __syncthreads();
        pass3_stage<DK, DV>(R, lds, tid);
        if (q + nblk < total) { const int qn = q + nblk; const int cl2 = qn / NU, uu2 = qn % NU, it2 = cl2 * 24 + U0 + uu2; const size_t r02 = (size_t)cl2 * 128;
            const bf16_t* qs2 = RET ? proj + r02 * NPROJ + uu2 * 64 : xbc + r02 * 2048 + 1536 + (uu2 >> 2) * 128;
            const bf16_t* ks2 = RET ? proj + r02 * NPROJ + 512 + uu2 * 64 : xbc + r02 * 2048 + 1024 + (uu2 >> 2) * 128;
            const bf16_t* vs2 = RET ? proj + r02 * NPROJ + 1024 + uu2 * 128 : xbc + r02 * 2048 + uu2 * 64;
            pass3_load<DK, DV>(R, qs2, ks2, kl_, vs2, kl_, states + (size_t)it2 * 16384, coef + (size_t)it2 * 512, tid); }
        __syncthreads();
        const float dsum = RET ? 0.f : a->in[24][uu_] + a->in[24][16 + uu_];
        bf16_t* dm_ = (bf16_t*)(a->out + (size_t)HROWS * DM) + r0_ * 2048;
        if (dummy) pass3_compute<DK, DV>(lds, RET ? 0.125f : 1.f, dsum, RET ? dm_ + uu_ * 64 : dm_ + 1024 + uu_ * 64, RET ? dm_ + 512 + uu_ * 64 : dm_ + 1024 + uu_ * 64, 2048, lane, wave, true);
        else pass3_compute<DK, DV>(lds, RET ? 0.125f : 1.f, dsum, RET ? qs_ : vs_, RET ? ks_ : vs_, kl_, lane, wave, true);
    }
    __syncthreads();
#undef P3_SRC
}
__device__ __forceinline__ void phase_pass3(KAP a, LAS unsigned char* lds, int tid, int lane, int wave, int blk, int nblk, bool dummy) {
    pass3_run<64, 128, true>(a, lds, tid, lane, wave, blk, nblk, dummy);
    pass3_run<128, 64, false>(a, lds, tid, lane, wave, blk, nblk, dummy);
}
__device__ __forceinline__ void p2_decode(int eg, int u, int b, int& elem, int& dir, size_t& sidx, int& sstride) {
    int vv, dcol, d0;
    if (u < 8) { vv = eg >> 4; dcol = (eg & 15) * 8; dir = dcol >> 6; d0 = dcol & 63; sidx = ((((size_t)b * 2 + dir) * 8 + u) * 64 + d0) * 128 + vv; sstride = 128; elem = vv * 128 + dcol; }
    else { vv = eg >> 5; dcol = (eg & 31) * 8; dir = dcol >> 7; d0 = dcol & 127; sidx = ((((size_t)b * 2 + dir) * 16 + (u - 8)) * 128 + d0) * 64 + vv; sstride = 64; elem = vv * 256 + dcol; }
}
#define PK8(o_, r_) do { (o_).x = pk2(r_[0], r_[1]); (o_).y = pk2(r_[2], r_[3]); (o_).z = pk2(r_[4], r_[5]); (o_).w = pk2(r_[6], r_[7]); } while (0)
__device__ __forceinline__ void phase_pass2(KAP a, int half, int tid, int blk, int nblk) {
    bf16_t* states = (bf16_t*)(a->ws + WS_STATES); const float* dec = (const float*)(a->ws + WS_DEC);
    const int T = nblk * 512, t0 = blk * 512 + tid;
    if (half == 0) {
        const int total = 32 * 24 * 2048;
        for (int base = t0; base < total; base += 4 * T) {
            u32x4 wa[4], wb[4]; float Aa[4], Ab[4]; bf16_t* pa[4]; bf16_t* pb[4]; size_t sidx[4]; int sstr[4]; bool ok[4]; int uu[4];
#pragma unroll
            for (int g = 0; g < 4; ++g) { const int gid = base + g * T; ok[g] = gid < total; const int gg = ok[g] ? gid : t0;
                const int eg = gg & 2047, t = gg >> 11, u = t % 24, b = t / 24; int elem, dir; p2_decode(eg, u, b, elem, dir, sidx[g], sstr[g]); uu[g] = u;
                const int ca = dir ? 1 : 0, cb = 1 - ca; const int ia = (2 * b + ca) * 24 + u, ib = (2 * b + cb) * 24 + u;
                pa[g] = states + (size_t)ia * 16384 + elem; pb[g] = states + (size_t)ib * 16384 + elem;
                wa[g] = *(const u32x4*)pa[g]; wb[g] = *(const u32x4*)pb[g]; Aa[g] = dec[ia * 2 + dir]; Ab[g] = dec[ib * 2 + dir]; }
#pragma unroll
            for (int g = 0; g < 4; ++g) { if (ok[g]) { float fa[8], fb[8], run[8]; UNPACK8(wa[g], fa); UNPACK8(wb[g], fb);
                { unsigned z0 = 0u; asm volatile("" : "+v"(z0)); *(u32x4*)pa[g] = (u32x4){z0, z0, z0, z0}; }
                u32x4 o; PK8(o, fa); *(u32x4*)pb[g] = o;
#pragma unroll
                for (int e = 0; e < 8; ++e) run[e] = Ab[g] * fa[e] + fb[e];
                float* op = a->out + (uu[g] < 8 ? OUT_SRET : OUT_SSSM) + sidx[g];
#pragma unroll
                for (int e = 0; e < 8; ++e) op[(size_t)e * sstr[g]] = run[e]; } }
        }
    }
    {
        const int nsamp = half == 0 ? 3 : 5, b0 = half == 0 ? 0 : 3, cbase = half == 0 ? 64 : 0; const int total = nsamp * 24 * 2048;
        for (int gid = t0; gid < total; gid += T) {
            const int eg = gid & 2047, t = gid >> 11, u = t % 24, s = t / 24, b = b0 + s, c0 = cbase + 32 * s;
            int elem, dir, sstride; size_t sidx; p2_decode(eg, u, b, elem, dir, sidx, sstride);
            float run[8]; { const float* sp = (u < 8 ? a->in[2] : a->in[3]) + sidx;
#pragma unroll
                for (int e = 0; e < 8; ++e) run[e] = sp[(size_t)e * sstride]; }
            bf16_t* pbase = states + (size_t)u * 16384 + elem; const float* dbase = dec + u * 2 + dir;
            const int cstart = dir ? c0 + 31 : c0, cstep = dir ? -1 : 1;
            u32x4 w0[8], w1[8]; float A0[8], A1[8];
#pragma unroll
            for (int i = 0; i < 8; ++i) { const int c = cstart + cstep * i; w0[i] = *(const u32x4*)(pbase + (size_t)c * 24 * 16384); A0[i] = dbase[c * 48]; }
#pragma unroll
            for (int bt = 0; bt < 4; ++bt) {
                if (bt < 3) {
#pragma unroll
                    for (int i = 0; i < 8; ++i) { const int c = cstart + cstep * (8 * (bt + 1) + i);
                        if (bt & 1) { w0[i] = *(const u32x4*)(pbase + (size_t)c * 24 * 16384); A0[i] = dbase[c * 48]; } else { w1[i] = *(const u32x4*)(pbase + (size_t)c * 24 * 16384); A1[i] = dbase[c * 48]; } } }
#pragma unroll
                for (int i = 0; i < 8; ++i) { const int c = cstart + cstep * (8 * bt + i); float f[8];
                    if (bt & 1) { UNPACK8(w1[i], f); } else { UNPACK8(w0[i], f); }
                    const float A = (bt & 1) ? A1[i] : A0[i];
                    u32x4 o; PK8(o, run); *(u32x4*)(pbase + (size_t)c * 24 * 16384) = o;
#pragma unroll
                    for (int e = 0; e < 8; ++e) run[e] = A * run[e] + f[e]; }
            }
        }
    }
}

__device__ __forceinline__ void phase_gate(KAP a, int lane, int wave, int blk, int nblk) {
    const bf16_t* proj = (const bf16_t*)(a->ws + WS_PROJ); const bf16_t* xbc = (const bf16_t*)(a->ws + WS_H); bf16_t* yg = (bf16_t*)(a->ws + WS_YG);
    for (int rr = blk * 8 + wave; rr < HROWS; rr += nblk * 8) {
        const bf16_t* prow = proj + (size_t)rr * NPROJ; bf16_t* orow = yg + (size_t)rr * 2048;
        {   const int h = lane >> 3, vv0 = (lane & 7) * 16; const int col = vv0 < 64 ? h * 64 + vv0 : 512 + h * 64 + vv0 - 64;
            float y[16], g[16];
            { const u32x4 w0 = *(const u32x4*)(prow + col), w1 = *(const u32x4*)(prow + col + 8); float t0[8], t1[8]; UNPACK8(w0, t0); UNPACK8(w1, t1);
#pragma unroll
              for (int e = 0; e < 8; ++e) { y[e] = t0[e]; y[8 + e] = t1[e]; } }
            { const u32x4 w0 = *(const u32x4*)(prow + 2048 + h * 128 + vv0), w1 = *(const u32x4*)(prow + 2048 + h * 128 + vv0 + 8); float t0[8], t1[8]; UNPACK8(w0, t0); UNPACK8(w1, t1);
#pragma unroll
              for (int e = 0; e < 8; ++e) { g[e] = t0[e]; g[8 + e] = t1[e]; } }
            float s = 0.f;
#pragma unroll
            for (int e = 0; e < 16; ++e) s += y[e];
            s += shx(s, 1, lane); s += shx(s, 2, lane); s += shx(s, 4, lane);
            const float mean = s * (1.f / 128.f); float q = 0.f;
#pragma unroll
            for (int e = 0; e < 16; ++e) { y[e] -= mean; q += y[e] * y[e]; }
            q += shx(q, 1, lane); q += shx(q, 2, lane); q += shx(q, 4, lane);
            const float rstd = 1.0f / sqrtf(q * (1.f / 128.f) + 1e-6f);
            const float* gn = a->in[19] + h * 128 + vv0; float o[16];
#pragma unroll
            for (int e = 0; e < 16; ++e) o[e] = silu_f(g[e]) * (y[e] * rstd * gn[e]);
            u32x4 w0, w1; w0.x = pk2(o[0], o[1]); w0.y = pk2(o[2], o[3]); w0.z = pk2(o[4], o[5]); w0.w = pk2(o[6], o[7]);
            w1.x = pk2(o[8], o[9]); w1.y = pk2(o[10], o[11]); w1.z = pk2(o[12], o[13]); w1.w = pk2(o[14], o[15]);
            *(u32x4*)(orow + h * 128 + vv0) = w0; *(u32x4*)(orow + h * 128 + vv0 + 8) = w1; }
        {   const bf16_t* xr = xbc + (size_t)rr * 2048 + lane * 16; const bf16_t* zr = prow + 3072 + lane * 16;
            float y[16], z[16];
            { const u32x4 w0 = *(const u32x4*)(xr), w1 = *(const u32x4*)(xr + 8); float t0[8], t1[8]; UNPACK8(w0, t0); UNPACK8(w1, t1);
#pragma unroll
              for (int e = 0; e < 8; ++e) { y[e] = t0[e]; y[8 + e] = t1[e]; } }
            { const u32x4 w0 = *(const u32x4*)(zr), w1 = *(const u32x4*)(zr + 8); float t0[8], t1[8]; UNPACK8(w0, t0); UNPACK8(w1, t1);
#pragma unroll
              for (int e = 0; e < 8; ++e) { z[e] = t0[e]; z[8 + e] = t1[e]; } }
            float ss = 0.f;
#pragma unroll
            for (int e = 0; e < 16; ++e) { y[e] = y[e] * silu_f(z[e]); ss += y[e] * y[e]; }
            const float rstd = 1.0f / sqrtf(wave_sum(ss, lane) * (1.f / 1024.f) + 1e-6f);
            const float* ng = a->in[25] + lane * 16; float o[16];
#pragma unroll
            for (int e = 0; e < 16; ++e) o[e] = y[e] * rstd * ng[e];
            u32x4 w0, w1; w0.x = pk2(o[0], o[1]); w0.y = pk2(o[2], o[3]); w0.z = pk2(o[4], o[5]); w0.w = pk2(o[6], o[7]);
            w1.x = pk2(o[8], o[9]); w1.y = pk2(o[10], o[11]); w1.z = pk2(o[12], o[13]); w1.w = pk2(o[14], o[15]);
            *(u32x4*)(orow + 1024 + lane * 16) = w0; *(u32x4*)(orow + 1024 + lane * 16 + 8) = w1; }
    }
}

constexpr float ATT_C2 = 0.125f * 1.4426950408889634f;
__device__ __forceinline__ void phase_attn_prep(KAP a, LAS unsigned char* lds, int tid, int lane, int wave, int blk, int nblk) {
    bf16_t* qkv = (bf16_t*)(a->ws + WS_QKV); bf16_t* kcat = (bf16_t*)(a->ws + WS_KCAT); bf16_t* vcat = (bf16_t*)(a->ws + WS_VCAT); bf16_t* kp = (bf16_t*)(a->ws + WS_KP); bf16_t* vp = (bf16_t*)(a->ws + WS_VP);
    LAS bf16_t* vt = (LAS bf16_t*)lds;
    const int d0 = (lane & 3) * 16, sub = lane & 3;
    for (int unit = blk; unit < MROWS / 64; unit += nblk) {
        const int r0 = unit * 64; const bool smp = r0 >= PROWS; int b, t0; if (smp) { b = (r0 - PROWS) >> 12; t0 = (r0 - PROWS) & 4095; } else { b = r0 >> 8; t0 = r0 & 255; }
        u32x4 nq0, nq1, nk0, nk1;
        { const bf16_t* qr_ = qkv + (size_t)(r0 + 8 * wave) * NQKV; nq0 = *(const u32x4*)(qr_ + lane * 16); nq1 = *(const u32x4*)(qr_ + lane * 16 + 8);
          nk0 = *(const u32x4*)(qr_ + 1024 + (lane & 31) * 16); nk1 = *(const u32x4*)(qr_ + 1024 + (lane & 31) * 16 + 8); }
        for (int rl = 0; rl < 8; ++rl) {
            const int row = r0 + 8 * wave + rl, t = t0 + 8 * wave + rl; bf16_t* qrow = qkv + (size_t)row * NQKV;
            const u32x4 cq0 = nq0, cq1 = nq1, ck0 = nk0, ck1 = nk1;
            if (rl < 7) { const bf16_t* qn_ = qrow + NQKV; nq0 = *(const u32x4*)(qn_ + lane * 16); nq1 = *(const u32x4*)(qn_ + lane * 16 + 8);
                nk0 = *(const u32x4*)(qn_ + 1024 + (lane & 31) * 16); nk1 = *(const u32x4*)(qn_ + 1024 + (lane & 31) * 16 + 8); }
            float cs[16], sn[16];
            if (smp) { const float posv = (sub >> 1) ? (float)(t & 63) : (float)(t >> 6);
#pragma unroll
                for (int e = 0; e < 16; ++e) { const float ang = posv * exp2f(-0.83048202f * (float)e); const float rev = ang * 0.15915494309f; cs[e] = __builtin_amdgcn_cosf(rev); sn[e] = __builtin_amdgcn_sinf(rev); } }
            {
                float f[16]; { const u32x4 w0 = cq0, w1 = cq1; float t0_[8], t1_[8]; UNPACK8(w0, t0_); UNPACK8(w1, t1_);
#pragma unroll
                    for (int e = 0; e < 8; ++e) { f[e] = t0_[e]; f[8 + e] = t1_[e]; } }
                float ss = 0.f;
#pragma unroll
                for (int e = 0; e < 16; ++e) ss += f[e] * f[e];
                ss += shx(ss, 1, lane); ss += shx(ss, 2, lane);
                const float rstd = 1.0f / sqrtf(ss * (1.f / 64.f) + 1e-6f);
#pragma unroll
                for (int e = 0; e < 16; ++e) f[e] = f[e] * rstd * a->in[27][d0 + e];
                if (smp) {
#pragma unroll
                    for (int e = 0; e < 16; ++e) { const float o = shx(f[e], 1, lane); f[e] = (sub & 1) ? (o * sn[e] + f[e] * cs[e]) : (f[e] * cs[e] - o * sn[e]); } }
                u32x4 w0, w1; w0.x = pk2(f[0] * ATT_C2, f[1] * ATT_C2); w0.y = pk2(f[2] * ATT_C2, f[3] * ATT_C2); w0.z = pk2(f[4] * ATT_C2, f[5] * ATT_C2); w0.w = pk2(f[6] * ATT_C2, f[7] * ATT_C2);
                w1.x = pk2(f[8] * ATT_C2, f[9] * ATT_C2); w1.y = pk2(f[10] * ATT_C2, f[11] * ATT_C2); w1.z = pk2(f[12] * ATT_C2, f[13] * ATT_C2); w1.w = pk2(f[14] * ATT_C2, f[15] * ATT_C2);
                *(u32x4*)(qrow + lane * 16) = w0; *(u32x4*)(qrow + lane * 16 + 8) = w1; }
            {
                const int l5 = lane & 31; float f[16]; u32x4 w0, w1;
                { w0 = ck0; w1 = ck1; float t0_[8], t1_[8]; UNPACK8(w0, t0_); UNPACK8(w1, t1_);
#pragma unroll
                    for (int e = 0; e < 8; ++e) { f[e] = t0_[e]; f[8 + e] = t1_[e]; } }
                float ss = 0.f;
#pragma unroll
                for (int e = 0; e < 16; ++e) ss += f[e] * f[e];
                ss += shx(ss, 1, lane); ss += shx(ss, 2, lane);
                const float rstd = 1.0f / sqrtf(ss * (1.f / 64.f) + 1e-6f);
                float kf[16];
#pragma unroll
                for (int e = 0; e < 16; ++e) kf[e] = f[e] * rstd * a->in[28][d0 + e];
                float kr[16];
#pragma unroll
                for (int e = 0; e < 16; ++e) { const float o = shx(kf[e], 1, lane); kr[e] = smp ? ((sub & 1) ? (o * sn[e] + kf[e] * cs[e]) : (kf[e] * cs[e] - o * sn[e])) : kf[e]; }
                if (lane < 16) { const int kvh = lane >> 2;
                    if (!smp) { float* ok = a->out + OUT_CK + (size_t)row * 256 + lane * 16;
#pragma unroll
                        for (int e = 0; e < 16; e += 4) *(f32x4*)(ok + e) = (f32x4){kf[e], kf[e + 1], kf[e + 2], kf[e + 3]}; }
                    bf16_t* kd = smp ? kcat + ((size_t)(b * 4 + kvh) * LKEYS + 256 + t) * 64 + d0 : kp + ((size_t)(b * 4 + kvh) * 256 + t) * 64 + d0;
                    u32x4 o0, o1; o0.x = pk2(kr[0], kr[1]); o0.y = pk2(kr[2], kr[3]); o0.z = pk2(kr[4], kr[5]); o0.w = pk2(kr[6], kr[7]);
                    o1.x = pk2(kr[8], kr[9]); o1.y = pk2(kr[10], kr[11]); o1.z = pk2(kr[12], kr[13]); o1.w = pk2(kr[14], kr[15]);
                    *(u32x4*)kd = o0; *(u32x4*)(kd + 8) = o1; }
                else if (lane < 32) { const int vl = lane - 16;
                    if (!smp) { float* ov = a->out + OUT_CV + (size_t)row * 256 + vl * 16;
#pragma unroll
                        for (int e = 0; e < 16; e += 4) *(f32x4*)(ov + e) = (f32x4){f[e], f[e + 1], f[e + 2], f[e + 3]}; }
                    LAS bf16_t* vd = vt + (8 * wave + rl) * 264 + vl * 16; *(LAS u32x4*)vd = w0; *(LAS u32x4*)(vd + 8) = w1; } }
        }
        __syncthreads();
        {   const int p = tid >> 1, hf = tid & 1, kvh = p >> 6, d = p & 63; unsigned w[16];
#pragma unroll
            for (int i = 0; i < 16; ++i) { const int o0 = 2 * i, k0 = 16 * (o0 >> 4) + ((o0 & 3) | ((o0 & 4) << 1) | ((o0 & 8) >> 1));
                w[i] = (unsigned)vt[(32 * hf + k0) * 264 + p] | ((unsigned)vt[(32 * hf + k0 + 1) * 264 + p] << 16); }
            bf16_t* vd = smp ? vcat + ((size_t)(b * 4 + kvh) * 64 + d) * LKEYS + 256 + t0 + 32 * hf : vp + ((size_t)(b * 4 + kvh) * 64 + d) * 256 + t0 + 32 * hf;
#pragma unroll
            for (int i = 0; i < 4; ++i) *(u32x4*)(vd + 8 * i) = (u32x4){w[4 * i], w[4 * i + 1], w[4 * i + 2], w[4 * i + 3]}; }
        __syncthreads();
    }
    for (int i = blk * 512 + tid; i < 8 * 4 * 256 * 64; i += nblk * 512) {
        { const int d = i & 63, key = (i >> 6) & 255, kvh = (i >> 14) & 3, b = i >> 16;
          kcat[((size_t)(b * 4 + kvh) * LKEYS + key) * 64 + d] = f2bf1(a->in[4][((size_t)(b * 256 + key) * 4 + kvh) * 64 + d]); }
        { const int pos = i & 255, d = (i >> 8) & 63, kvh = (i >> 14) & 3, b = i >> 16; const int key = (pos & ~15) + ((pos & 3) | ((pos & 4) << 1) | ((pos & 8) >> 1));
          vcat[((size_t)(b * 4 + kvh) * 64 + d) * LKEYS + pos] = f2bf1(a->in[5][((size_t)(b * 256 + key) * 4 + kvh) * 64 + d]); }
    }
}

#define MX3(a_, b_, c_) __builtin_fmaxf(__builtin_fmaxf((a_), (b_)), (c_))
constexpr int ATT_BUF = 18432, ATT_VOFF = 9216, ATT_QOFF = 3 * ATT_BUF;
__device__ __forceinline__ void phase_attn(KAP a, LAS unsigned char* lds, int tid, int lane, int wave, int blk, int nblk) {
    const bf16_t* qkv = (const bf16_t*)(a->ws + WS_QKV); bf16_t* O = (bf16_t*)(a->ws + WS_O);
    const int vcu = (nblk % 8 == 0) ? (blk % 8) * (nblk / 8) + blk / 8 : blk;
    const int hi = lane >> 5, l31 = lane & 31, lrow = tid >> 3, lch = (tid & 7) * 8;
    constexpr float THR = 6.0f;
    for (int u = vcu; u < 1280; u += nblk) {
        const bf16_t* kb; const bf16_t* vb; int vld, nkeys, qrow0, kvh;
        if (u < 1024) { const int b = u >> 7; kvh = (u >> 5) & 3; const int qb = u & 31; kb = (const bf16_t*)(a->ws + WS_KCAT) + (size_t)(b * 4 + kvh) * LKEYS * 64;
            vb = (const bf16_t*)(a->ws + WS_VCAT) + (size_t)(b * 4 + kvh) * 64 * LKEYS; vld = LKEYS; nkeys = LKEYS; qrow0 = PROWS + b * 4096 + qb * 128; }
        else { const int u2 = u - 1024, b = u2 >> 3; kvh = (u2 >> 1) & 3; const int qb = u2 & 1; kb = (const bf16_t*)(a->ws + WS_KP) + (size_t)(b * 4 + kvh) * 256 * 64;
            vb = (const bf16_t*)(a->ws + WS_VP) + (size_t)(b * 4 + kvh) * 64 * 256; vld = 256; nkeys = 256; qrow0 = b * 256 + qb * 128; }
        const int head = kvh * 4 + (wave & 3); const int qrow = qrow0 + 64 * (wave >> 2) + l31;
        LAS bf16x8* Qs = (LAS bf16x8*)(lds + ATT_QOFF) + wave * 512 + lane;
#pragma unroll
        for (int dd = 0; dd < 4; ++dd) { Qs[dd * 64] = *(const bf16x8*)(qkv + (size_t)qrow * NQKV + head * 64 + 16 * dd + 8 * hi);
            Qs[(4 + dd) * 64] = *(const bf16x8*)(qkv + (size_t)(qrow + 32) * NQKV + head * 64 + 16 * dd + 8 * hi); }
        f32x16 oA0 = {}, oA1 = {}, oB0 = {}, oB1 = {}; f32x16 ngA = {}; float mA = 0.f, lA = 0.f, lB = 0.f;
        const int NTL = nkeys / 64;
        const bf16_t* kg = kb + (size_t)lrow * 64 + lch; const bf16_t* vg = vb + (size_t)lrow * vld + lch;
        u32x4 kreg = *(const u32x4*)kg, vreg = *(const u32x4*)vg;
        __syncthreads();
        *(LAS u32x4*)((LAS bf16_t*)lds + lrow * 72 + lch) = kreg; *(LAS u32x4*)((LAS bf16_t*)(lds + ATT_VOFF) + lrow * 72 + lch) = vreg;
        kreg = *(const u32x4*)(kg + 64 * 64); vreg = *(const u32x4*)(vg + 64);
        __syncthreads();
#define ATT_S(Kt_) do { pA0 = ngA; pA1 = ngA; pB0 = ngA; pB1 = ngA; __builtin_amdgcn_s_setprio(1); \
            _Pragma("unroll") for (int dd = 0; dd < 4; ++dd) { \
                const bf16x8 k0 = *(const LAS bf16x8*)((Kt_) + l31 * 72 + 16 * dd + 8 * hi), k1 = *(const LAS bf16x8*)((Kt_) + (32 + l31) * 72 + 16 * dd + 8 * hi); \
                const bf16x8 qa = Qs[dd * 64], qb2 = Qs[(4 + dd) * 64]; \
                pA0 = __builtin_amdgcn_mfma_f32_32x32x16_bf16(k0, qa, pA0, 0, 0, 0); pA1 = __builtin_amdgcn_mfma_f32_32x32x16_bf16(k1, qa, pA1, 0, 0, 0); \
                pB0 = __builtin_amdgcn_mfma_f32_32x32x16_bf16(k0, qb2, pB0, 0, 0, 0); pB1 = __builtin_amdgcn_mfma_f32_32x32x16_bf16(k1, qb2, pB1, 0, 0, 0); \
                __builtin_amdgcn_sched_barrier(0); } __builtin_amdgcn_s_setprio(0); } while (0)
#define ATT_EXP(p0_, p1_, l_, pk_) do { float ls0 = 0.f, ls1 = 0.f; \
            _Pragma("unroll") for (int r = 0; r < 16; ++r) { p0_[r] = __builtin_amdgcn_exp2f(p0_[r]); p1_[r] = __builtin_amdgcn_exp2f(p1_[r]); ls0 += p0_[r]; ls1 += p1_[r]; } \
            l_ += ls0 + ls1; \
            pk_[0] = (u32x4){pk2(p0_[0], p0_[1]), pk2(p0_[2], p0_[3]), pk2(p0_[4], p0_[5]), pk2(p0_[6], p0_[7])}; \
            pk_[1] = (u32x4){pk2(p0_[8], p0_[9]), pk2(p0_[10], p0_[11]), pk2(p0_[12], p0_[13]), pk2(p0_[14], p0_[15])}; \
            pk_[2] = (u32x4){pk2(p1_[0], p1_[1]), pk2(p1_[2], p1_[3]), pk2(p1_[4], p1_[5]), pk2(p1_[6], p1_[7])}; \
            pk_[3] = (u32x4){pk2(p1_[8], p1_[9]), pk2(p1_[10], p1_[11]), pk2(p1_[12], p1_[13]), pk2(p1_[14], p1_[15])}; } while (0)
#define ATT_SM(first_) do { \
            float ma = MX3(pA0[0], pA1[0], pB0[0]), mb = MX3(pB1[0], pA0[1], pA1[1]); \
            _Pragma("unroll") for (int r = 1; r < 16; ++r) { ma = MX3(ma, pA0[r], pA1[r]); mb = MX3(mb, pB0[r], pB1[r]); } \
            float rm = __builtin_fmaxf(ma, mb); rm = __builtin_fmaxf(rm, shx(rm, 32, lane)); \
            if (__any(rm > THR || rm < -20.f)) { const float dl = __builtin_fmaxf(rm, -60.f); mA += dl; \
                _Pragma("unroll") for (int r = 0; r < 16; ++r) { pA0[r] -= dl; pA1[r] -= dl; pB0[r] -= dl; pB1[r] -= dl; ngA[r] = -mA; } \
                const float f = __builtin_amdgcn_exp2f(-dl); lA *= f; lB *= f; \
                _Pragma("unroll") for (int r = 0; r < 16; ++r) { oA0[r] *= f; oA1[r] *= f; oB0[r] *= f; oB1[r] *= f; } } \
            ATT_EXP(pA0, pA1, lA, pkA); __builtin_amdgcn_sched_barrier(0); ATT_EXP(pB0, pB1, lB, pkB); __builtin_amdgcn_sched_barrier(0); } while (0)
#define ATT_PV(Vt_) do { __builtin_amdgcn_s_setprio(1); _Pragma("unroll") for (int s = 0; s < 4; ++s) { \
                const bf16x8 v0 = *(const LAS bf16x8*)((Vt_) + l31 * 72 + 16 * s + 8 * hi), v1 = *(const LAS bf16x8*)((Vt_) + (32 + l31) * 72 + 16 * s + 8 * hi); \
                const bf16x8 fa = __builtin_bit_cast(bf16x8, pkA[s]), fb = __builtin_bit_cast(bf16x8, pkB[s]); \
                oA0 = __builtin_amdgcn_mfma_f32_32x32x16_bf16(v0, fa, oA0, 0, 0, 0); oA1 = __builtin_amdgcn_mfma_f32_32x32x16_bf16(v1, fa, oA1, 0, 0, 0); \
                oB0 = __builtin_amdgcn_mfma_f32_32x32x16_bf16(v0, fb, oB0, 0, 0, 0); oB1 = __builtin_amdgcn_mfma_f32_32x32x16_bf16(v1, fb, oB1, 0, 0, 0); \
                __builtin_amdgcn_sched_barrier(0); } __builtin_amdgcn_s_setprio(0); } while (0)
#define ATT_STAGE(t_) do { if ((t_) + 1 < NTL) { LAS bf16_t* Kn = (LAS bf16_t*)(lds + slot_next * ATT_BUF); \
                *(LAS u32x4*)(Kn + lrow * 72 + lch) = kreg; *(LAS u32x4*)(Kn + 4608 + lrow * 72 + lch) = vreg; \
                if ((t_) + 2 < NTL) { kreg = *(const u32x4*)(kg + (size_t)((t_) + 2) * 64 * 64); vreg = *(const u32x4*)(vg + ((t_) + 2) * 64); } } } while (0)
        if (wave < 4) {
            int slot = 0;
#pragma nounroll
            for (int t = 0; t <= NTL; ++t) {
                const int slot_next = (slot == 2) ? 0 : slot + 1;
                ATT_STAGE(t);
                if (t < NTL) { LAS bf16_t* Kt = (LAS bf16_t*)(lds + slot * ATT_BUF); LAS bf16_t* Vt = Kt + 4608;
                    u32x4 pkA[4], pkB[4]; f32x16 pA0, pA1, pB0, pB1;
                    ATT_S(Kt); ATT_SM(t == 0); ATT_PV(Vt); }
                slot = slot_next;
                __syncthreads();
            }
        } else {
            int slot = 0, slot_prev = 0;
            u32x4 pkA[4], pkB[4];
#pragma unroll
            for (int i = 0; i < 4; ++i) { pkA[i] = (u32x4){0u, 0u, 0u, 0u}; pkB[i] = (u32x4){0u, 0u, 0u, 0u}; }
#pragma nounroll
            for (int t = 0; t <= NTL; ++t) {
                const int slot_next = (slot == 2) ? 0 : slot + 1;
                ATT_STAGE(t);
                if (t > 0) { LAS bf16_t* Vp = (LAS bf16_t*)(lds + slot_prev * ATT_BUF) + 4608; ATT_PV(Vp); }
                if (t < NTL) { LAS bf16_t* Kt = (LAS bf16_t*)(lds + slot * ATT_BUF); f32x16 pA0, pA1, pB0, pB1; ATT_S(Kt); ATT_SM(t == 0); }
                slot_prev = slot; slot = slot_next;
                __syncthreads();
            }
        }
#define ATT_STORE(o0_, o1_, l_, qr_) do { l_ += shx(l_, 32, lane); const float inv = 1.0f / l_; bf16_t* orow = O + (size_t)(qr_) * DM + head * 64 + 4 * hi; \
        _Pragma("unroll") for (int g = 0; g < 4; ++g) { \
            *(u32x2*)(orow + 8 * g) = (u32x2){pk2(o0_[4 * g] * inv, o0_[4 * g + 1] * inv), pk2(o0_[4 * g + 2] * inv, o0_[4 * g + 3] * inv)}; \
            *(u32x2*)(orow + 32 + 8 * g) = (u32x2){pk2(o1_[4 * g] * inv, o1_[4 * g + 1] * inv), pk2(o1_[4 * g + 2] * inv, o1_[4 * g + 3] * inv)}; } } while (0)
        ATT_STORE(oA0, oA1, lA, qrow);
        ATT_STORE(oB0, oB1, lB, qrow + 32);
    }
}

__global__ void __launch_bounds__(512) hybrid_fwd(KArgs ka) {
    extern __shared__ __attribute__((aligned(16))) unsigned char lds_raw[];
    LAS unsigned char* lds_k = (LAS unsigned char*)lds_raw;
    cg::grid_group grid = cg::this_grid();
    const int tid_k = threadIdx.x, blk_k = blockIdx.x, nblk_k = gridDim.x; const int wave_k = __builtin_amdgcn_readfirstlane(tid_k >> 6);
#ifndef PHMASK
#define PHMASK 0xFFFF
#endif
#define EN(n) (((PHMASK) >> (n)) & 1)
#ifndef REPMASK
#define REPMASK 0
#endif
#define REPS(n) for (int rep_ = 0; rep_ < 1 + (((REPMASK) >> (n)) & 1); ++rep_)
    bool seq_done = false; (void)seq_done;
    volatile LAS unsigned* bst = (volatile LAS unsigned*)(lds_k + LDS_BYTES - 16);
    if (tid_k < 4) bst[tid_k] = 0u;
    __syncthreads();
    XcdBarrier xbar = xcd_barrier_post((unsigned*)ka.ws, bst);
    for (int ph = ka.lo; ph < ka.hi; ++ph) {
        int tid, wv_ = wave_k; asm volatile("" : "+s"(wv_)); asm volatile("v_mbcnt_lo_u32_b32 %0, -1, 0\n\tv_mbcnt_hi_u32_b32 %0, -1, %0" : "=v"(tid)); tid += wv_ * 64; int blk = blk_k, nblk = nblk_k; unsigned ldsu = 0; KAP a = (KAP)__builtin_amdgcn_kernarg_segment_ptr(); asm volatile("" : "+s"(a)); unsigned char* ws = a->ws; float* X = a->out;
        asm volatile("" : "+v"(tid)); asm volatile("" : "+s"(blk)); asm volatile("" : "+s"(nblk)); asm volatile("" : "+s"(ws)); asm volatile("" : "+s"(X)); asm volatile("" : "+s"(ldsu));
        const int lane = tid & 63, wave = __builtin_amdgcn_readfirstlane(tid >> 6);
        LAS unsigned char* lds = lds_k + ldsu;
        const float* MOD = (const float*)(ws + WS_MOD); bf16_t* H = (bf16_t*)(ws + WS_H);
        int kind, half = 0, layer = 0;
        if (ph == 0) kind = 0;
        else if (ph <= 15) { const int st = ph <= 8 ? ph - 1 : ph - 8; half = ph > 8; kind = st + 1; }
        else if (ph <= 19 || ph >= 25) { layer = ph >= 25; const int idx = ph - (layer ? 25 : 16);
            if (idx == 0) kind = 12; else if (idx == 1) kind = 13; else { kind = 14; half = idx - 2; } }
        else { layer = 1; kind = ph == 20 ? 15 : ph == 21 ? 16 : ph == 22 ? 9 : ph == 23 ? 10 : 17; }
        const int grow0 = half * HROWS;
        const float* modl = MOD + layer * 9 * 6144;
        if (kind == 0) { if (EN(0)) REPS(0) phase_prologue(a, lds, tid, lane, wave, blk, nblk); }
        else if (kind == 1 || kind == 12 || kind == 15) {
            const float* x0; const float* x1; const float* nw; int sh_off, row0, nrows;
            if (kind == 1) { x0 = a->in[0]; x1 = a->in[1]; nw = a->in[10]; sh_off = 0; row0 = grow0; nrows = HROWS; }
            else if (kind == 15) { x0 = X; x1 = X + (size_t)PROWS * DM; nw = a->in[10] + DM; sh_off = 0; row0 = HROWS; nrows = HROWS; }
            else { x0 = X; x1 = X + (size_t)PROWS * DM; nw = a->in[11] + layer * DM; sh_off = 3072; row0 = layer ? 0 : HROWS; nrows = layer ? MROWS : HROWS; }
            if (EN(1)) REPS(1) phase_norm(x0, x1, nw, modl, sh_off, sh_off + 1024, row0, nrows, H + (size_t)(kind == 1 ? 0 : row0) * DM, (float*)nullptr, lane, wave, blk, nblk);
        }
        else if (kind == 2 || kind == 13 || kind == 16) {
            const bf16_t* Ap; const bf16_t* Bp; bf16_t* Op; int Mr, Nc, ldo;
            if (kind == 2) { Ap = H; Bp = (const bf16_t*)(ws + WS_WIN); Mr = HROWS; Nc = NPROJ_PAD; Op = (bf16_t*)(ws + WS_PROJ); ldo = NPROJ; }
            else if (kind == 13) { Ap = H + (size_t)grow0 * DM; Bp = (const bf16_t*)(ws + (layer ? WS_WUP1 : WS_WUP0)); Mr = HROWS; Nc = FFU; Op = (bf16_t*)(ws + WS_ACT); ldo = FFH; }
            else { Ap = H; Bp = (const bf16_t*)(ws + WS_WQKV); Mr = MROWS; Nc = NQKV; Op = (bf16_t*)(ws + WS_QKV); ldo = NQKV; }
            if (kind == 13) { if (EN(11)) { pg8::Gemm g{Ap, Bp, Mr, Nc, 1024, 1}; pg8::StaticOrder S; S.init(Mr, Nc, nblk, blk);
                pg8::EpiConvFfn E{Op, (float*)(ws + WS_EDGE), a->in[13] + (size_t)layer * 3 * FFU, a->in[14] + (size_t)layer * FFU, 0, (LAS float*)(lds + 131072)};
                pg8::gemm_phase<pg8::EpiConvFfn, pg8::StaticOrder, true, true>(lds, g, S, E, tid); } }
            else if (EN(2)) REPS(2) { pg8::Gemm g{Ap, Bp, Mr, Nc, 1024, 1}; pg8::StaticOrder S; S.init(Mr, Nc, nblk, blk);
                pg8::EpiStoreBf16 E{Op, ldo, ldo}; pg8::gemm_phase<pg8::EpiStoreBf16, pg8::StaticOrder, true, true>(lds, g, S, E, tid); }
        }
        else if (kind == 8 || kind == 14 || kind == 17) {
            const bf16_t* Ap; const bf16_t* Bp; const float* b0; const float* b1; const float* gp; int Mr, Kd, roff;
            if (kind == 8) { Ap = (const bf16_t*)(ws + WS_YG); Bp = (const bf16_t*)(ws + WS_WOUT); Mr = HROWS; Kd = 2048; b0 = a->in[0]; b1 = a->in[1]; gp = modl + 2048; roff = grow0; }
            else if (kind == 14) { Ap = (const bf16_t*)(ws + (half ? WS_ACT1 : WS_ACT)); Bp = (const bf16_t*)(ws + (layer ? WS_WDN1 : WS_WDN0)); Mr = HROWS; Kd = FFH; b0 = X; b1 = X + (size_t)PROWS * DM; gp = modl + 5120; roff = grow0; }
            else { Ap = (const bf16_t*)(ws + WS_O); Bp = (const bf16_t*)(ws + WS_WO); Mr = MROWS; Kd = 1024; b0 = X; b1 = X + (size_t)PROWS * DM; gp = modl + 2048; roff = 0; }
            if (kind == 14 && EN(8)) {
                pg8::StaticOrder S0; S0.init(Mr, DM, nblk, blk); pg8::Unit uu;
                for (int i = 0; S0.next(i, uu); ++i) ffn_seam_fixup((const float*)(ws + WS_EDGE), (bf16_t*)(ws + (half ? WS_ACT1 : WS_ACT)) + (size_t)uu.pm * 256 * FFH, a->in[13] + (size_t)layer * 3 * FFU, a->in[14] + (size_t)layer * FFU, (grow0 >> 8) + uu.pm, tid);
                asm volatile("s_waitcnt vmcnt(0)" ::: "memory"); __syncthreads(); }
            if (EN(8)) { pg8::Gemm g{Ap, Bp, Mr, DM, Kd, 1}; pg8::StaticOrder S; S.init(Mr, DM, nblk, blk);
                pg8::EpiResid E{b0, b1, X, gp, roff}; pg8::gemm_phase<pg8::EpiResid, pg8::StaticOrder, true, true>(lds, g, S, E, tid); }
            if (kind == 14 && half == 0 && EN(11)) {
                pg8::Gemm g{H + (size_t)HROWS * DM, (const bf16_t*)(ws + (layer ? WS_WUP1 : WS_WUP0)), HROWS, FFU, 1024, 1}; pg8::SkewOrder S; S.init(HROWS, FFU, nblk, blk);
                pg8::EpiConvFfn E{(bf16_t*)(ws + WS_ACT1), (float*)(ws + WS_EDGE), a->in[13] + (size_t)layer * 3 * FFU, a->in[14] + (size_t)layer * FFU, HROWS, (LAS float*)(lds + 131072)};
                pg8::gemm_phase<pg8::EpiConvFfn, pg8::SkewOrder, true, true>(lds, g, S, E, tid); }
            if (EN(1) && ((kind == 8 && half == 1) || (kind == 14 && half == 1 && layer == 0))) {
                const int skip = (nblk == 256) ? 64 : 0;
                if (blk >= skip) { if (kind == 8) phase_norm(X, X + (size_t)PROWS * DM, a->in[11], MOD, 3072, 4096, 0, HROWS, H, (float*)nullptr, lane, wave, blk - skip, nblk - skip);
                    else phase_norm(X, X + (size_t)PROWS * DM, a->in[10] + DM, MOD + 9 * 6144, 0, 1024, 0, HROWS, H, (float*)nullptr, lane, wave, blk - skip, nblk - skip); } }
            if (kind == 8 && half == 0 && EN(1)) {
                const int skip = (nblk == 256) ? 64 : 0;
                if (blk >= skip) phase_norm(a->in[0], a->in[1], a->in[10], modl, 0, 1024, HROWS, HROWS, H, (float*)nullptr, lane, wave, blk - skip, nblk - skip); }
        }
        else if (kind == 3) { if (EN(3)) REPS(3) { phase_conv_xbc((const bf16_t*)(ws + WS_PROJ), H, a->in[20], a->in[21], grow0, tid, blk, nblk); phase_coeffs(a, lane, wave, blk, nblk); } }
        else if (kind == 4) { if (EN(4)) REPS(4) phase_pass1(a, lds, tid, lane, wave, blk, nblk); }
        else if (kind == 5) { if (EN(5)) phase_pass2(a, half, tid, blk, nblk); }
        else if (kind == 6) { if (EN(6)) { phase_pass3(a, lds, tid, lane, wave, blk, nblk, false);
#ifdef P3REP
            if (half == 0) phase_pass3(a, lds, tid, lane, wave, blk, nblk, true);
#endif
        } }
        else if (kind == 7) { if (EN(7)) REPS(7) phase_gate(a, lane, wave, blk, nblk); }
        else if (kind == 9) { if (EN(9)) phase_attn_prep(a, lds, tid, lane, wave, blk, nblk); }
        else if (kind == 10) { if (EN(10)) REPS(10) phase_attn(a, lds, tid, lane, wave, blk, nblk); }
#ifdef XSYNC
        if (ph == 20) { for (int i_ = 0; i_ < XSYNC; ++i_) xcd_barrier(xbar); }
#endif
#ifdef SEQ_BEGIN
        if (ph == SEQ_END && !seq_done) { seq_done = true; ph = SEQ_BEGIN - 1; }
#endif
        if (ph + 1 < ka.hi) { if (ka.hi > 1000) grid.sync(); else xcd_barrier(xbar); }
    }
}
constexpr int NPHASES = 1 + 15 + 4 + 5 + 4;

#ifndef MK_PER_PHASE
#define MK_PER_PHASE 0
#endif
extern "C" void kernel_launch(void* const* d_in, const int* in_sizes, int n_in, void* d_out, int out_size, void* d_ws, size_t ws_size, hipStream_t stream) {
    static int grid = 0;
    if (grid == 0) {
        if (n_in != 30 || ws_size < WS_NEED) { fprintf(stderr, "kernel_launch: unexpected n_in %d / ws_size %zu\n", n_in, ws_size); grid = -1; return; }
        int dev = 0, cus = 0, per_cu = 0;
        hipGetDevice(&dev); hipDeviceGetAttribute(&cus, hipDeviceAttributeMultiprocessorCount, dev);
        if (hipFuncSetAttribute((const void*)hybrid_fwd, hipFuncAttributeMaxDynamicSharedMemorySize, LDS_BYTES) != hipSuccess) { fprintf(stderr, "kernel_launch: hipFuncSetAttribute failed\n"); grid = -1; return; }
        if (hipOccupancyMaxActiveBlocksPerMultiprocessor(&per_cu, (const void*)hybrid_fwd, 512, LDS_BYTES) != hipSuccess || per_cu < 1) { fprintf(stderr, "kernel_launch: occupancy query says %d\n", per_cu); per_cu = 1; }
        (void)hipGetLastError();
        grid = cus * per_cu;
        if (grid > 256) grid = 256;
        grid -= grid % 8;
    }
    if (grid <= 0) return;
    if (hipMemsetAsync(d_ws, 0, 16384, stream) != hipSuccess) { fprintf(stderr, "kernel_launch: memset of the barrier words failed\n"); return; }
    KArgs a{};
    for (int i = 0; i < 30; ++i) a.in[i] = (const float*)d_in[i];
    a.out = (float*)d_out; a.ws = (unsigned char*)d_ws;
#if MK_PER_PHASE
    for (int p = 0; p < NPHASES; ++p) { a.lo = p; a.hi = p + 1; hipLaunchKernelGGL(hybrid_fwd, dim3(grid), dim3(512), LDS_BYTES, stream, a); }
#else
    a.lo = 0; a.hi = NPHASES;
    void* args[] = {&a};
    hipError_t e = hipLaunchCooperativeKernel((const void*)hybrid_fwd, dim3(grid), dim3(512), args, LDS_BYTES, stream);
    if (e != hipSuccess) fprintf(stderr, "cooperative launch failed: %s (grid %d)\n", hipGetErrorString(e), grid);
#endif
}
```

```cpp
#include <hip/hip_runtime.h>
#include <hip/hip_cooperative_groups.h>
#include <cstdio>
#include <cstdint>
namespace cg = cooperative_groups;
namespace pg8 {
#define PG8_LAS __attribute__((address_space(3)))
typedef unsigned short bf16_t;
typedef short bf16x8 __attribute__((ext_vector_type(8)));
typedef float f32x4 __attribute__((ext_vector_type(4)));
typedef unsigned u32x4 __attribute__((ext_vector_type(4)));
constexpr int BM = 256, BK = 64, HALF = 128, HTB = HALF * BK * 2  , STAGE_BYTES = 8 * HTB, NXCD = 8, WGM = 4;

__host__ __device__ __forceinline__ int lds_byte(int r, int c) { const int st = (r >> 4) * 2 + (c >> 5), rr = r & 15, cc = c & 31, ob = rr * 64 + cc * 2; return st * 1024 + (ob ^ (((ob >> 9) & 1) << 5)); }
__host__ __device__ __forceinline__ void stage_rc(int b, int& R, int& C) { const int st = b / 1024, sb = b % 1024, swz = sb ^ (((sb >> 9) & 1) << 5); R = (st >> 1) * 16 + swz / 64; C = (st & 1) * 32 + (swz % 64) / 2; }
__host__ __device__ __forceinline__ int perm32(int rho) { const int n = rho >> 4, i = rho & 15; return 8 * (i >> 2) + 4 * n + (i & 3); }

struct Unit { int pm, pn, pk; };
struct Gemm { const bf16_t* A; const bf16_t* Bt; int M, N, K, ks; };

struct StaticOrder {
    int nM, nN, nwg, G, c, ks;
    __host__ __device__ void init(int M, int N, int G_, int c_, int ks_ = 1) { ks = ks_; nM = M / BM; nN = N / BM * ks_; nwg = nM * nN; G = G_; c = c_; }
    __host__ __device__ bool next(int i, Unit& u) const { const long L = (long)i * G + c; if (L >= nwg) return false; decode((int)L, u); return true; }
    __host__ __device__ bool decode(int Lid, Unit& u) const {
        int wgid = Lid; { const int q = nwg / NXCD, r = nwg % NXCD, xcd = wgid % NXCD, off = wgid / NXCD; wgid = (xcd < r ? xcd * (q + 1) : r * (q + 1) + (xcd - r) * q) + off; }
        const int nig = WGM * nN, gid = wgid / nig, fm = gid * WGM, gsz = (nM - fm) < WGM ? (nM - fm) : WGM;
        u.pm = fm + ((wgid % nig) % gsz); const int pq = (wgid % nig) / gsz; u.pn = pq / ks; u.pk = pq % ks; return true;
    }
    __device__ __forceinline__ void a_ready(const Unit&) const {}
    __device__ __forceinline__ void done(const Unit&) const {}
};
struct SkewOrder {
    StaticOrder B; int c, G;
    __host__ __device__ void init(int M, int N, int G_, int c_) { B.init(M, N, G_, c_); c = c_; G = G_; }
    __host__ __device__ bool next(int i, Unit& u) const {
        long L;
        if (G != 256) L = (long)i * G + c;
        else if (c < 64) { if (i >= 5) return false; L = (long)i * 64 + c; }
        else L = 320 + (c - 64) + (long)i * 192;
        if (L >= B.nwg) return false;
        B.decode((int)L, u); return true;
    }
    __device__ __forceinline__ void a_ready(const Unit&) const {}
    __device__ __forceinline__ void done(const Unit&) const {}
};

__device__ __forceinline__ unsigned cvt_pk_bf16(float lo, float hi) { unsigned r; asm volatile("v_cvt_pk_bf16_f32 %0, %1, %2" : "=v"(r) : "v"(lo), "v"(hi)); return r; }
typedef float f32x2 __attribute__((ext_vector_type(2)));
template <class Epi, class Sched, bool ALIGN_EPI = false, bool SP2 = false>
__device__ __forceinline__ void gemm_phase(PG8_LAS unsigned char* lds, const Gemm g, const Sched& S, const Epi& E, const int tid) {
    const int  wid = __builtin_amdgcn_readfirstlane(tid >> 6), lane = tid & 63, wr = wid >> 2, wc = wid & 3, fr = lane & 15, fq = lane >> 4;
    const int K = g.K, nt = K / g.ks / BK; const size_t kext = (size_t)(K / g.ks) * 2;
    unsigned voffA[2], voffB[2];
#pragma unroll
    for (int i = 0; i < 2; ++i) { int R, C; stage_rc(tid * 16 + i * 8192, R, C); const int Rb = Epi::PERM ? ((R & ~31) + perm32(R & 31)) : R;
        voffA[i] = (unsigned)(R * K + C) * 2u; voffB[i] = (unsigned)(Rb * K + C) * 2u; }
    const size_t kstep = (size_t)(BK * 2);
    const size_t hstep = (size_t)HALF * K * 2;
    const size_t tstep = 2 * hstep;
    const unsigned ldsw = (unsigned)wid * 1024u;
    const int aoff = lds_byte(wr * 64 + fr, fq * 8), boff = lds_byte(wc * 32 + fr, fq * 8);
#define PG8_SA(b, h) (((b) * 2 + (h)) * HTB)
#define PG8_SB(b, h) ((4 + (b) * 2 + (h)) * HTB)
#define PG8_STAGE(bufoff, gbase, voff) do { _Pragma("unroll") for (int _i = 0; _i < 2; ++_i) \
        __builtin_amdgcn_global_load_lds((const unsigned*)((const char*)(gbase) + (voff)[_i]), (PG8_LAS unsigned*)(lds + (bufoff) + ldsw + _i * 8192), 16, 0, 0); } while (0)
#define PG8_LDA(dst, b, h) do { _Pragma("unroll") for (int m = 0; m < 4; ++m) _Pragma("unroll") for (int k = 0; k < 2; ++k) dst[m][k] = *(const PG8_LAS bf16x8*)(lds + PG8_SA(b, h) + aoff + m * 2048 + k * 1024); } while (0)
#define PG8_LDB(dst, b, h) do { _Pragma("unroll") for (int n = 0; n < 2; ++n) _Pragma("unroll") for (int k = 0; k < 2; ++k) dst[n][k] = *(const PG8_LAS bf16x8*)(lds + PG8_SB(b, h) + boff + n * 2048 + k * 1024); } while (0)
#define PG8_MMA(ai, bj, At, Bt) do { __builtin_amdgcn_s_setprio(1); _Pragma("unroll") for (int m = 0; m < 4; ++m) _Pragma("unroll") for (int n = 0; n < 2; ++n) _Pragma("unroll") for (int k = 0; k < 2; ++k) \
        acc[ai][bj][m][n] = __builtin_amdgcn_mfma_f32_16x16x32_bf16(Bt[n][k], At[m][k], acc[ai][bj][m][n], 0, 0, 0); __builtin_amdgcn_s_setprio(0); } while (0)
#define PG8_WAIT_V(n) asm volatile("s_waitcnt vmcnt(" #n ")" ::: "memory")
#define PG8_WAIT_L(n) asm volatile("s_waitcnt lgkmcnt(" #n ")" ::: "memory")
#define PG8_BAR __builtin_amdgcn_s_barrier()
#define PG8_SCHED __builtin_amdgcn_sched_barrier(0)
    Unit cur, nxt; int ui = 0;
    if (!S.next(0, cur)) return;
    f32x4 acc[2][2][4][2];
#pragma unroll
    for (int a = 0; a < 2; ++a)
#pragma unroll
        for (int b = 0; b < 2; ++b)
#pragma unroll
            for (int m = 0; m < 4; ++m)
#pragma unroll
                for (int n = 0; n < 2; ++n) acc[a][b][m][n] = (f32x4){0.f, 0.f, 0.f, 0.f};
    bf16x8 At[4][2], B0[2][2], B1[2][2];
    const char* cA = (const char*)g.A + (size_t)cur.pm * tstep + cur.pk * kext; const char* cB = (const char*)g.Bt + (size_t)cur.pn * tstep + cur.pk * kext;
    S.a_ready(cur);
    if constexpr (SP2) {
        PG8_STAGE(PG8_SB(0, 0), cB, voffB); PG8_STAGE(PG8_SB(0, 1), cB + hstep, voffB); PG8_STAGE(PG8_SA(0, 0), cA, voffA); PG8_STAGE(PG8_SA(0, 1), cA + hstep, voffA);
        if (wr == 1) PG8_BAR;
        PG8_WAIT_V(2); PG8_BAR;
        PG8_STAGE(PG8_SB(1, 0), cB + kstep, voffB); PG8_STAGE(PG8_SA(1, 0), cA + kstep, voffA); PG8_STAGE(PG8_SB(1, 1), cB + hstep + kstep, voffB);
        PG8_WAIT_V(6); PG8_BAR;
    } else {
        PG8_STAGE(PG8_SB(0, 0), cB, voffB); PG8_STAGE(PG8_SA(0, 0), cA, voffA); PG8_STAGE(PG8_SB(0, 1), cB + hstep, voffB); PG8_STAGE(PG8_SA(0, 1), cA + hstep, voffA);
        if (wr == 1) PG8_BAR;
        PG8_WAIT_V(4); PG8_BAR;
        PG8_STAGE(PG8_SB(1, 0), cB + kstep, voffB); PG8_STAGE(PG8_SA(1, 0), cA + kstep, voffA); PG8_STAGE(PG8_SB(1, 1), cB + hstep + kstep, voffB);
        PG8_WAIT_V(6); PG8_BAR;
    }
    for (;;) {
        const bool has_next = S.next(ui + 1, nxt);
        const char* nA = has_next ? (const char*)g.A + (size_t)nxt.pm * tstep + nxt.pk * kext : cA; const char* nB = has_next ? (const char*)g.Bt + (size_t)nxt.pn * tstep + nxt.pk * kext : cB;
        for (int t = 0; t < nt; t += 2) {
            const bool last = (t == nt - 2);
            const char* a1 = cA + (size_t)(t + 1) * kstep;
            const char* a2 = last ? nA : cA + (size_t)(t + 2) * kstep; const char* b2 = last ? nB : cB + (size_t)(t + 2) * kstep;
            const char* a3 = a2 + kstep; const char* b3 = b2 + kstep;
            if (last && has_next) S.a_ready(nxt);
            if constexpr (SP2) {
            PG8_LDB(B0, 0, 0); PG8_LDB(B1, 0, 1); PG8_SCHED; PG8_LDA(At, 0, 0); PG8_STAGE(PG8_SA(1, 1), a1 + hstep, voffA);
            PG8_WAIT_V(8); PG8_WAIT_L(0); PG8_BAR; PG8_MMA(0, 0, At, B0); PG8_MMA(0, 1, At, B1); PG8_BAR; PG8_SCHED;
            PG8_LDA(At, 0, 1); PG8_STAGE(PG8_SB(0, 0), b2, voffB); PG8_STAGE(PG8_SB(0, 1), b2 + hstep, voffB); PG8_STAGE(PG8_SA(0, 0), a2, voffA);
            PG8_WAIT_V(8); PG8_WAIT_L(0); PG8_BAR; PG8_MMA(1, 0, At, B0); PG8_MMA(1, 1, At, B1); PG8_BAR; PG8_SCHED;
            PG8_LDB(B0, 1, 0); PG8_LDB(B1, 1, 1); PG8_SCHED; PG8_LDA(At, 1, 0); PG8_STAGE(PG8_SA(0, 1), a2 + hstep, voffA);
            PG8_WAIT_V(8); PG8_WAIT_L(0); PG8_BAR; PG8_MMA(0, 0, At, B0); PG8_MMA(0, 1, At, B1); PG8_BAR; PG8_SCHED;
            PG8_LDA(At, 1, 1); PG8_STAGE(PG8_SB(1, 0), b3, voffB); PG8_STAGE(PG8_SB(1, 1), b3 + hstep, voffB); PG8_STAGE(PG8_SA(1, 0), a3, voffA);
            PG8_WAIT_V(8); PG8_WAIT_L(0); PG8_BAR; PG8_MMA(1, 0, At, B0); PG8_MMA(1, 1, At, B1); PG8_BAR; PG8_SCHED;
            } else {
            PG8_LDB(B0, 0, 0); PG8_SCHED; PG8_LDA(At, 0, 0); PG8_STAGE(PG8_SA(1, 1), a1 + hstep, voffA);
            PG8_WAIT_L(8); PG8_BAR; PG8_WAIT_L(0); PG8_MMA(0, 0, At, B0); PG8_BAR; PG8_SCHED;
            PG8_LDB(B1, 0, 1); PG8_STAGE(PG8_SB(0, 0), b2, voffB);
            PG8_BAR; PG8_WAIT_L(0); PG8_MMA(0, 1, At, B1); PG8_BAR;
            PG8_LDA(At, 0, 1); PG8_STAGE(PG8_SA(0, 0), a2, voffA);
            PG8_BAR; PG8_WAIT_L(0); PG8_MMA(1, 0, At, B0); PG8_BAR; PG8_SCHED;
            PG8_STAGE(PG8_SB(0, 1), b2 + hstep, voffB);
            PG8_WAIT_V(6); PG8_BAR; PG8_MMA(1, 1, At, B1); PG8_BAR;
            PG8_LDB(B0, 1, 0); PG8_SCHED; PG8_LDA(At, 1, 0); PG8_STAGE(PG8_SA(0, 1), a2 + hstep, voffA);
            PG8_WAIT_L(8); PG8_BAR; PG8_WAIT_L(0); PG8_MMA(0, 0, At, B0); PG8_BAR; PG8_SCHED;
            PG8_LDB(B1, 1, 1); PG8_STAGE(PG8_SB(1, 0), b3, voffB);
            PG8_BAR; PG8_WAIT_L(0); PG8_MMA(0, 1, At, B1); PG8_BAR;
            PG8_LDA(At, 1, 1); PG8_STAGE(PG8_SA(1, 0), a3, voffA);
            PG8_BAR; PG8_WAIT_L(0); PG8_MMA(1, 0, At, B0); PG8_BAR; PG8_SCHED;
            PG8_STAGE(PG8_SB(1, 1), b3 + hstep, voffB);
            PG8_WAIT_V(6); PG8_BAR; PG8_MMA(1, 1, At, B1); PG8_BAR;
            }
        }
        if constexpr (ALIGN_EPI) { if (wr == 0) PG8_BAR; }
        if constexpr (!Epi::AFTER_DRAIN) { E(acc, cur, wr, wc, fr, fq); S.done(cur); }
        if (!has_next) break;
#pragma unroll
        for (int a = 0; a < 2; ++a)
#pragma unroll
            for (int b = 0; b < 2; ++b)
#pragma unroll
                for (int m = 0; m < 4; ++m)
#pragma unroll
                    for (int n = 0; n < 2; ++n) acc[a][b][m][n] = (f32x4){0.f, 0.f, 0.f, 0.f};
        cur = nxt; cA = nA; cB = nB; ++ui;
        if constexpr (ALIGN_EPI) { if (wr == 1) PG8_BAR; }
    }
    PG8_WAIT_V(0);
    if constexpr (!ALIGN_EPI) { if (wr == 0) PG8_BAR; }
    PG8_BAR;
    if constexpr (Epi::AFTER_DRAIN) { E.fused(acc, cur, wr, wc, fr, fq, lds, wid, lane); S.done(cur); }
#undef PG8_SA
#undef PG8_SB
#undef PG8_STAGE
#undef PG8_LDA
#undef PG8_LDB
#undef PG8_MMA
#undef PG8_WAIT_V
#undef PG8_WAIT_L
#undef PG8_BAR
#undef PG8_SCHED
}
}

#define LAS __attribute__((address_space(3)))
typedef unsigned short bf16_t;
typedef short bf16x8 __attribute__((ext_vector_type(8)));
typedef short s16x4 __attribute__((ext_vector_type(4)));
typedef float f32x4 __attribute__((ext_vector_type(4)));
typedef float f32x2v __attribute__((ext_vector_type(2)));
typedef float f32x16 __attribute__((ext_vector_type(16)));
typedef unsigned u32x4 __attribute__((ext_vector_type(4)));
typedef unsigned u32x2 __attribute__((ext_vector_type(2)));
typedef __bf16 bf16x2n __attribute__((ext_vector_type(2)));

constexpr int DM = 1024, MROWS = 40960, PROWS = 8192, HROWS = 20480;
constexpr int NPROJ = 6160, NPROJ_PAD = 6400, FFH = 2816, FFU = 5632, NQKV = 1536;
constexpr int LKEYS = 4352;
constexpr size_t MiB = 1u << 20;
constexpr size_t WS_MOD = 1 * MiB, WS_WIN = 2 * MiB, WS_WOUT = 15 * MiB, WS_WUP0 = 19 * MiB, WS_WUP1 = 30 * MiB, WS_WDN0 = 41 * MiB, WS_WDN1 = 47 * MiB,
                 WS_WQKV = 53 * MiB, WS_WO = 56 * MiB, WS_H = 58 * MiB, WS_BIG = 138 * MiB;
constexpr size_t WS_PROJ = WS_BIG, WS_STATES = 379 * MiB, WS_YG = 379 * MiB, WS_DEC = 500 * MiB, WS_COEF = 501 * MiB, WS_EDGE = 470 * MiB;
constexpr size_t WS_ACT1 = WS_BIG, WS_ACT = 358 * MiB;
constexpr size_t WS_QKV = WS_BIG, WS_KCAT = 258 * MiB, WS_VCAT = 276 * MiB, WS_KP = 294 * MiB, WS_VP = 298 * MiB, WS_O = 302 * MiB;
constexpr size_t WS_NEED = 510 * MiB;
constexpr int LDS_BYTES = 147456;
constexpr size_t OUT_SRET = 41943040, OUT_SSSM = 46137344, OUT_CK = 54525952, OUT_CV = 56623104;

__device__ __forceinline__ unsigned pk2(float lo, float hi) { f32x2v v = {lo, hi}; bf16x2n b = __builtin_convertvector(v, bf16x2n); return __builtin_bit_cast(unsigned, b); }
__device__ __forceinline__ float bflo(unsigned w) { return __builtin_bit_cast(float, w << 16); }
__device__ __forceinline__ float bfhi(unsigned w) { return __builtin_bit_cast(float, w & 0xffff0000u); }
__device__ __forceinline__ float bf2f(bf16_t b) { return __builtin_bit_cast(float, (unsigned)b << 16); }
__device__ __forceinline__ bf16_t f2bf1(float f) { return (bf16_t)(pk2(f, 0.f) & 0xffffu); }
__device__ __forceinline__ float silu_f(float x) { return x * __builtin_amdgcn_rcpf(1.f + __expf(-x)); }
__device__ __forceinline__ int crow(int r, int hi) { return (r & 3) + 8 * (r >> 2) + 4 * hi; }
__device__ __forceinline__ int cond_of(int grow) { return grow < PROWS ? 0 : 1 + ((grow - PROWS) >> 12); }
__device__ __forceinline__ float shx(float v, int o, int lane) { return __builtin_bit_cast(float, __builtin_amdgcn_ds_bpermute((lane ^ o) << 2, __builtin_bit_cast(int, v))); }
__device__ __forceinline__ float shidx(float v, int idx) { return __builtin_bit_cast(float, __builtin_amdgcn_ds_bpermute(idx << 2, __builtin_bit_cast(int, v))); }
__device__ __forceinline__ float wave_sum(float v, int lane) {
#pragma unroll
    for (int o = 1; o < 64; o <<= 1) v += shx(v, o, lane);
    return v;
}
#define UNPACK8(W_, F_) do { F_[0] = bflo((W_).x); F_[1] = bfhi((W_).x); F_[2] = bflo((W_).y); F_[3] = bfhi((W_).y); F_[4] = bflo((W_).z); F_[5] = bfhi((W_).z); F_[6] = bflo((W_).w); F_[7] = bfhi((W_).w); } while (0)

namespace pg8 {
struct EpiStoreBf16 {
    static constexpr bool PERM = true, AFTER_DRAIN = false;
    bf16_t* O; int ldc; int ncols;
    __device__ __forceinline__ void operator()(const f32x4 (&acc)[2][2][4][2], const Unit& u, int wr, int wc, int fr, int fq) const {
        const int row0 = u.pm * BM + wr * 64 + fr; const int col0 = u.pn * BM + wc * 32 + 8 * fq;
#pragma unroll
        for (int ai = 0; ai < 2; ++ai)
#pragma unroll
            for (int m = 0; m < 4; ++m) { bf16_t* rowp = O + (size_t)(row0 + ai * HALF + m * 16) * ldc + col0;
#pragma unroll
                for (int bj = 0; bj < 2; ++bj) { if (col0 + bj * HALF < ncols) { const f32x4 v0 = acc[ai][bj][m][0], v1 = acc[ai][bj][m][1];
                    u32x4 w; w.x = ::pk2(v0[0], v0[1]); w.y = ::pk2(v0[2], v0[3]); w.z = ::pk2(v1[0], v1[1]); w.w = ::pk2(v1[2], v1[3]);
                    *(u32x4*)(rowp + bj * HALF) = w; } } }
    }
};
struct EpiResid {
    static constexpr bool PERM = false, AFTER_DRAIN = false;
    const float* base0; const float* base1; float* out; const float* gate; int row_off;
    __device__ __forceinline__ void operator()(const f32x4 (&acc)[2][2][4][2], const Unit& u, int wr, int wc, int fr, int fq) const {
#pragma unroll
        for (int ai = 0; ai < 2; ++ai)
#pragma unroll
            for (int m = 0; m < 4; ++m) { const int grow = row_off + u.pm * BM + ai * HALF + wr * 64 + m * 16 + fr;
                const int cnd = grow < PROWS ? 0 : 1 + ((grow - PROWS) >> 12);
                const float* bp = grow < PROWS ? base0 + (size_t)grow * DM : base1 + (size_t)(grow - PROWS) * DM;
                const float* gp = gate + cnd * 6144; float* op = out + (size_t)grow * DM;
#pragma unroll
                for (int bj = 0; bj < 2; ++bj)
#pragma unroll
                    for (int n = 0; n < 2; ++n) { const int col = u.pn * BM + bj * HALF + wc * 32 + n * 16 + 4 * fq;
                        const f32x4 b = *(const f32x4*)(bp + col), g = *(const f32x4*)(gp + col);
                        *(f32x4*)(op + col) = b + g * acc[ai][bj][m][n]; } }
    }
};
template <int CTRL> __device__ __forceinline__ float dpp_f(float oldv, float src) { return __builtin_bit_cast(float, __builtin_amdgcn_update_dpp(__builtin_bit_cast(int, oldv), __builtin_bit_cast(int, src), CTRL, 0xf, 0xf, false)); }
#define DPP4(res_, old_, src_, ctrl_) do { (res_)[0] = dpp_f<ctrl_>((old_)[0], (src_)[0]); (res_)[1] = dpp_f<ctrl_>((old_)[1], (src_)[1]); (res_)[2] = dpp_f<ctrl_>((old_)[2], (src_)[2]); (res_)[3] = dpp_f<ctrl_>((old_)[3], (src_)[3]); } while (0)
struct EpiConvFfn {
    static constexpr bool PERM = true, AFTER_DRAIN = false;
    bf16_t* act; float* edge; const float* cw; const float* cb; int grow0; PG8_LAS float* xch;
    __device__ __forceinline__ void operator()(const f32x4 (&acc)[2][2][4][2], const Unit& u, int wr, int wc, int fr, int fq) const {
        asm volatile("" : "+v"(fr), "+v"(fq));
        int chl = wc * 32 + 8 * fq;
        asm volatile("" : "+v"(chl));
        const int grow_t = grow0 + u.pm * BM; const int gt = grow_t >> 8;
        bool seq_first, seq_last; if (grow_t < PROWS) { seq_first = true; seq_last = true; } else { const int pos = (grow_t - PROWS) & 4095; seq_first = pos == 0; seq_last = pos == 4096 - 256; }
#pragma unroll
        for (int ai = 0; ai < 2; ++ai) { const int b = 2 * ai + wr;
#pragma unroll
            for (int bj = 0; bj < 2; ++bj)
#pragma unroll
                for (int n = 0; n < 2; ++n) {
                    if (fr == 0) *(PG8_LAS f32x4*)(xch + (b * 2 + 0) * 256 + bj * 128 + chl + 4 * n) = acc[ai][bj][0][n];
                    if (fr == 15) *(PG8_LAS f32x4*)(xch + (b * 2 + 1) * 256 + bj * 128 + chl + 4 * n) = acc[ai][bj][3][n];
                    if (b == 0 && fr < 2) *(f32x4*)(edge + ((size_t)gt * 4 + fr) * FFU + u.pn * BM + bj * 128 + chl + 4 * n) = acc[ai][bj][0][n];
                    if (b == 3 && fr >= 14) *(f32x4*)(edge + ((size_t)gt * 4 + fr - 12) * FFU + u.pn * BM + bj * 128 + chl + 4 * n) = acc[ai][bj][3][n]; } }
        asm volatile("s_waitcnt lgkmcnt(0)" ::: "memory"); __builtin_amdgcn_s_barrier(); asm volatile("" ::: "memory");
        typedef unsigned u32x2_t __attribute__((ext_vector_type(2)));
#pragma unroll
        for (int n = 0; n < 2; ++n) {
            const int ch = u.pn * 128 + chl + 4 * n;
#pragma unroll
            for (int ai = 0; ai < 2; ++ai) { const int b = 2 * ai + wr;
                f32x4 sg[4];
#pragma unroll
                for (int bj = 0; bj < 2; ++bj) { const int wi = bj * FFH + ch;
                    const f32x4 w0 = *(const f32x4*)(cw + wi), w1 = *(const f32x4*)(cw + FFU + wi), w2 = *(const f32x4*)(cw + 2 * FFU + wi), bb = *(const f32x4*)(cb + wi);
                    f32x4 pv_edge = (f32x4){0.f, 0.f, 0.f, 0.f}, nx_edge = (f32x4){0.f, 0.f, 0.f, 0.f};
                    if (b > 0) pv_edge = *(const PG8_LAS f32x4*)(xch + ((b - 1) * 2 + 1) * 256 + bj * 128 + chl + 4 * n);
                    if (b < 3) nx_edge = *(const PG8_LAS f32x4*)(xch + ((b + 1) * 2 + 0) * 256 + bj * 128 + chl + 4 * n);
#pragma unroll
                    for (int m = 0; m < 4; ++m) { const f32x4 v = acc[ai][bj][m][n];
                        f32x4 fbp, fbn, pv, nx;
                        if (m > 0) { DPP4(fbp, v, acc[ai][bj][m - 1][n], 0x121); } else fbp = pv_edge;
                        if (m < 3) { DPP4(fbn, v, acc[ai][bj][m + 1][n], 0x12F); } else fbn = nx_edge;
                        DPP4(pv, fbp, v, 0x111);
                        DPP4(nx, fbn, v, 0x101);
                        const f32x4 c = w0 * pv + w1 * v + w2 * nx + bb;
                        if (bj == 0) {
#pragma unroll
                            for (int e = 0; e < 4; ++e) sg[m][e] = ::silu_f(c[e]); }
                        else { const f32x4 o = sg[m] * c;
                            const int r = ai * HALF + wr * 64 + m * 16 + fr;
                            const bool skip = (r == 0 && !seq_first) || (r == 255 && !seq_last);
                            if (!skip) *(u32x2_t*)(act + (size_t)(u.pm * BM + r) * FFH + ch) = (u32x2_t){::pk2(o[0], o[1]), ::pk2(o[2], o[3])}; } } }
                asm volatile("" ::: "memory"); }
        }
    }
};
}

template <int KT> __device__ __forceinline__ void mma_tile(f32x16& acc, const LAS bf16_t* A, int lda, const LAS bf16_t* B, int ldb, int lane) {
    const int r = lane & 31, h = lane >> 5;
    const LAS bf16_t* ap = A + r * lda + 8 * h; const LAS bf16_t* bp = B + r * ldb + 8 * h;
#pragma unroll 4
    for (int k = 0; k < KT; k += 16) { const bf16x8 a = *(const LAS bf16x8*)(ap + k); const bf16x8 b = *(const LAS bf16x8*)(bp + k);
        acc = __builtin_amdgcn_mfma_f32_32x32x16_bf16(a, b, acc, 0, 0, 0); }
}

struct KArgs { const float* in[30]; float* out; unsigned char* ws; int lo, hi; };
typedef const __attribute__((address_space(4))) KArgs* KAP;

__device__ __forceinline__ void transpose_item(const float* W, int ldn, int K, int nblk, bf16_t* WT, LAS float* scr, int item, int lane, bool upmap = false) {
    const int kb = item / nblk, nb = item % nblk, k0 = 64 * kb, n0 = 32 * nb;
    int nd = n0;
    if (upmap) { const int isv = n0 >= FFH, c = isv ? n0 - FFH : n0; nd = (c >> 7) * 256 + isv * 128 + (c & 127); }
#pragma unroll 8
    for (int i = 0; i < 32; ++i) { const int kk = 2 * i + (lane >> 5); scr[kk * 33 + (lane & 31)] = W[(size_t)(k0 + kk) * ldn + n0 + (lane & 31)]; }
    asm volatile("s_waitcnt lgkmcnt(0)" ::: "memory");
    const int c = lane & 7;
#pragma unroll
    for (int j = 0; j < 4; ++j) { const int n = (lane >> 3) + 8 * j; const LAS float* s = scr + (8 * c) * 33 + n;
        u32x4 o; o.x = pk2(s[0 * 33], s[1 * 33]); o.y = pk2(s[2 * 33], s[3 * 33]); o.z = pk2(s[4 * 33], s[5 * 33]); o.w = pk2(s[6 * 33], s[7 * 33]);
        *(u32x4*)(WT + (size_t)(nd + n) * K + k0 + 8 * c) = o; }
    asm volatile("s_waitcnt lgkmcnt(0)" ::: "memory");
}

__device__ __forceinline__ void phase_prologue(KAP a, LAS unsigned char* lds, int tid, int lane, int wave, int blk, int nblk) {
    unsigned char* ws = a->ws;
    {
        LAS float* sc = (LAS float*)lds; LAS float* red = sc + 9 * 1024;
        float* MOD = (float*)(ws + WS_MOD);
        for (int unit = blk; unit < 192; unit += nblk) {
            for (int i = tid; i < 9 * 1024; i += 512) { const int c = i >> 10, k = i & 1023; const float v = (c == 0) ? a->in[7][k] : a->in[6][(c - 1) * 1024 + k]; sc[i] = silu_f(v); }
            __syncthreads();
            const int l = unit / 96, j0 = (unit % 96) * 64;
            const float* w = a->in[8] + (size_t)l * 1024 * 6144 + j0 + lane;
            float s0 = 0, s1 = 0, s2 = 0, s3 = 0, s4 = 0, s5 = 0, s6 = 0, s7 = 0, s8 = 0;
#pragma unroll 8
            for (int k = wave * 128; k < wave * 128 + 128; ++k) { const float wv = w[(size_t)k * 6144];
                s0 += sc[k] * wv; s1 += sc[1024 + k] * wv; s2 += sc[2048 + k] * wv; s3 += sc[3072 + k] * wv; s4 += sc[4096 + k] * wv;
                s5 += sc[5120 + k] * wv; s6 += sc[6144 + k] * wv; s7 += sc[7168 + k] * wv; s8 += sc[8192 + k] * wv; }
            LAS float* rp = red + wave * 576 + lane;
            rp[0] = s0; rp[64] = s1; rp[128] = s2; rp[192] = s3; rp[256] = s4; rp[320] = s5; rp[384] = s6; rp[448] = s7; rp[512] = s8;
            __syncthreads();
            for (int i = tid; i < 576; i += 512) { float s = 0.f;
#pragma unroll
                for (int w8 = 0; w8 < 8; ++w8) s += red[w8 * 576 + i];
                const int c = i >> 6, ln = i & 63; MOD[(l * 9 + c) * 6144 + j0 + ln] = s + a->in[9][l * 6144 + j0 + ln]; }
            __syncthreads();
        }
    }
    __syncthreads();
    {
        LAS float* scr = (LAS float*)(lds + wave * 16384);
        const int gw = blk * 8 + wave, NGW = nblk * 8;
        constexpr int I_IN = 16 * 192, I_OUT = 32 * 32, I_UP = 16 * 176, I_DN = 44 * 32, I_QKV = 16 * 48, I_WO = 16 * 32;
        constexpr int NITEMS = I_IN + I_OUT + 2 * I_UP + 2 * I_DN + I_QKV + I_WO;
        for (int it = gw; it < NITEMS; it += NGW) {
            int r = it;
            if (r < I_IN) { transpose_item(a->in[16], NPROJ, 1024, 192, (bf16_t*)(ws + WS_WIN), scr, r, lane); continue; } r -= I_IN;
            if (r < I_OUT) { transpose_item(a->in[17], 1024, 2048, 32, (bf16_t*)(ws + WS_WOUT), scr, r, lane); continue; } r -= I_OUT;
            if (r < I_UP) { transpose_item(a->in[12], FFU, 1024, 176, (bf16_t*)(ws + WS_WUP0), scr, r, lane, true); continue; } r -= I_UP;
            if (r < I_UP) { transpose_item(a->in[12] + (size_t)1024 * FFU, FFU, 1024, 176, (bf16_t*)(ws + WS_WUP1), scr, r, lane, true); continue; } r -= I_UP;
            if (r < I_DN) { transpose_item(a->in[15], 1024, FFH, 32, (bf16_t*)(ws + WS_WDN0), scr, r, lane); continue; } r -= I_DN;
            if (r < I_DN) { transpose_item(a->in[15] + (size_t)FFH * 1024, 1024, FFH, 32, (bf16_t*)(ws + WS_WDN1), scr, r, lane); continue; } r -= I_DN;
            if (r < I_QKV) { transpose_item(a->in[26], NQKV, 1024, 48, (bf16_t*)(ws + WS_WQKV), scr, r, lane); continue; } r -= I_QKV;
            transpose_item(a->in[29], 1024, 1024, 32, (bf16_t*)(ws + WS_WO), scr, r, lane);
        }
        bf16_t* WIN = (bf16_t*)(ws + WS_WIN);
        for (int i = blk * 512 + tid; i < 256 * 1024; i += nblk * 512) { const int n = i >> 10, k = i & 1023;
            WIN[(size_t)(6144 + n) * 1024 + k] = (n < 16) ? f2bf1(a->in[16][(size_t)k * NPROJ + 6144 + n]) : (bf16_t)0; }
    }
}

__device__ __forceinline__ void phase_norm(const float* x0, const float* x1, const float* nw, const float* mod_l, int sh_off, int sc_off,
                                           int row0, int nrows, bf16_t* dst, float* xcopy, int lane, int wave, int blk, int nblk) {
    for (int rr = blk * 8 + wave; rr < nrows; rr += nblk * 8) {
        const int grow = row0 + rr; const int cnd = cond_of(grow);
        const float* xrow = grow < PROWS ? x0 + (size_t)grow * DM : x1 + (size_t)(grow - PROWS) * DM;
        const f32x4* xr = (const f32x4*)xrow + lane;
        f32x4 v[4]; float s = 0.f;
#pragma unroll
        for (int j = 0; j < 4; ++j) { v[j] = xr[64 * j]; s += (v[j].x * v[j].x + v[j].y * v[j].y) + (v[j].z * v[j].z + v[j].w * v[j].w); }
        if (xcopy) { f32x4* xo = (f32x4*)(xcopy + (size_t)grow * DM) + lane;
#pragma unroll
            for (int j = 0; j < 4; ++j) xo[64 * j] = v[j]; }
        const float rstd = 1.0f / sqrtf(wave_sum(s, lane) * (1.f / DM) + 1e-6f);
        const float* mp = mod_l + cnd * 6144;
        unsigned long long* o8 = (unsigned long long*)(dst + (size_t)rr * DM) + lane;
#pragma unroll
        for (int j = 0; j < 4; ++j) { const int col = 256 * j + 4 * lane;
            const f32x4 w = *(const f32x4*)(nw + col), sc = *(const f32x4*)(mp + sc_off + col), sh = *(const f32x4*)(mp + sh_off + col);
            const f32x4 h = v[j] * rstd * w * (sc + 1.0f) + sh;
            o8[64 * j] = (unsigned long long)pk2(h.x, h.y) | ((unsigned long long)pk2(h.z, h.w) << 32); }
    }
}

__device__ __forceinline__ void seq_pos(int grow, int& pos, int& len) { if (grow < PROWS) { pos = grow & 255; len = 256; } else { pos = (grow - PROWS) & 4095; len = 4096; } }

__device__ __forceinline__ void phase_conv_xbc(const bf16_t* proj, bf16_t* xbc, const float* cw, const float* cb, int grow0, int tid, int blk, int nblk) {
    const int nitems = (HROWS / 8) * 256;
    for (int it = blk * 512 + tid; it < nitems; it += nblk * 512) {
        const int cg8 = it & 255, run = it >> 8, c = cg8 * 8, r0 = run * 8;
        int pos, len; seq_pos(grow0 + r0, pos, len);
        const bf16_t* src = proj + (size_t)r0 * NPROJ + 4096 + c;
        u32x4 w[10];
#pragma unroll
        for (int i = 0; i < 10; ++i) { const bool ok = (i == 0) ? (pos > 0) : (i == 9 ? (pos + 8 < len) : true);
            const u32x4 t_ = *(const u32x4*)(src + (ptrdiff_t)(ok ? i - 1 : 0) * NPROJ); w[i].x = ok ? t_.x : 0u; w[i].y = ok ? t_.y : 0u; w[i].z = ok ? t_.z : 0u; w[i].w = ok ? t_.w : 0u; }
        float w0[8], w1[8], w2[8], bb[8];
#pragma unroll
        for (int e = 0; e < 8; e += 4) { const f32x4 a0 = *(const f32x4*)(cw + c + e), a1 = *(const f32x4*)(cw + 2048 + c + e), a2 = *(const f32x4*)(cw + 4096 + c + e), a3 = *(const f32x4*)(cb + c + e);
#pragma unroll
            for (int k = 0; k < 4; ++k) { w0[e + k] = a0[k]; w1[e + k] = a1[k]; w2[e + k] = a2[k]; bb[e + k] = a3[k]; } }
        float p[8], q[8], n[8];
        UNPACK8(w[0], p); UNPACK8(w[1], q);
#pragma unroll
        for (int i = 0; i < 8; ++i) {
            UNPACK8(w[i + 2], n);
            float o[8];
#pragma unroll
            for (int e = 0; e < 8; ++e) { o[e] = silu_f(p[e] * w0[e] + q[e] * w1[e] + n[e] * w2[e] + bb[e]); p[e] = q[e]; q[e] = n[e]; }
            u32x4 ww; ww.x = pk2(o[0], o[1]); ww.y = pk2(o[2], o[3]); ww.z = pk2(o[4], o[5]); ww.w = pk2(o[6], o[7]);
            *(u32x4*)(xbc + (size_t)(r0 + i) * 2048 + c) = ww;
        }
    }
}

constexpr int FFQ = 1408;
__device__ __forceinline__ void ffn_seam_fixup(const float* edge, bf16_t* act_tile, const float* cw, const float* cb, int gt, int tid) {
    const int grow_t = gt * 256; if (grow_t < PROWS) return;
    const int pos = (grow_t - PROWS) & 4095; const bool first = pos == 0, last = pos == 4096 - 256;
    for (int i = tid; i < 2 * FFH; i += 512) { const int which = i >= FFH, ch = which ? i - FFH : i;
        if ((which == 0 && first) || (which == 1 && last)) continue;
        const int ca = (ch >> 7) * 256 + (ch & 127), cvv = ca + 128;
        const float* e0; const float* e1; const float* e2;
        if (which == 0) { e0 = edge + ((size_t)(gt - 1) * 4 + 3) * FFU; e1 = edge + ((size_t)gt * 4 + 0) * FFU; e2 = edge + ((size_t)gt * 4 + 1) * FFU; }
        else { e0 = edge + ((size_t)gt * 4 + 2) * FFU; e1 = edge + ((size_t)gt * 4 + 3) * FFU; e2 = edge + ((size_t)(gt + 1) * 4 + 0) * FFU; }
        const float av = cw[ch] * e0[ca] + cw[FFU + ch] * e1[ca] + cw[2 * FFU + ch] * e2[ca] + cb[ch];
        const float vv = cw[FFH + ch] * e0[cvv] + cw[FFU + FFH + ch] * e1[cvv] + cw[2 * FFU + FFH + ch] * e2[cvv] + cb[FFH + ch];
        act_tile[(size_t)(which ? 255 : 0) * FFH + ch] = f2bf1(silu_f(av) * vv); }
}

#define XB_TMO      128
#define XB_XCNT(j)  (256  + 64 * (j))
#define XB_XSUB(j)  (1280 + 64 * (j))
#define XB_XGEN(j)  (2304 + 64 * (j))
#define XB_TOP      3328
#define XB_TOPGEN   3392
#define XCD_BAR_WORDS 3456
#define XB_SPIN_CAP (1u << 18)

__device__ __forceinline__ unsigned xb_ld(unsigned* p)              { return __hip_atomic_load(p, __ATOMIC_RELAXED, __HIP_MEMORY_SCOPE_AGENT); }
__device__ __forceinline__ unsigned xb_add(unsigned* p, unsigned v) { return __hip_atomic_fetch_add(p, v, __ATOMIC_RELAXED, __HIP_MEMORY_SCOPE_AGENT); }
__device__ __forceinline__ unsigned xb_xcc_id() { return (unsigned)__builtin_amdgcn_s_getreg((3 << 11) | 20) & 0xFu; }
#define XB_SPIN(cond, bar) do { unsigned _sp = 0; while (cond) { __builtin_amdgcn_s_sleep(1); \
    if ((++_sp & 255u) == 0u) { if (xb_ld(&(bar)[XB_TMO])) break; if (_sp > XB_SPIN_CAP) { atomicAdd(&(bar)[XB_TMO], 1u); break; } } } } while (0)

struct XcdBarrier {
    unsigned* bar; unsigned x;
    volatile LAS unsigned* st;
};

__device__ __forceinline__ XcdBarrier xcd_barrier_post(unsigned* bar, volatile LAS unsigned* st) {
    XcdBarrier b; b.bar = bar; b.x = xb_xcc_id(); b.st = st;
    if (threadIdx.x == 0) (void)xb_add(&bar[XB_XCNT(b.x)], 1u);
    return b;
}
__device__ __forceinline__ void xcd_barrier_complete(unsigned* bar, unsigned x, unsigned& nloc, unsigned& nx) {
    const unsigned G = gridDim.x * gridDim.y * gridDim.z;
    unsigned sum, cnt, mine, sp = 0u;
    for (;;) {
        sum = 0u; cnt = 0u; mine = 0u;
#pragma unroll
        for (unsigned j = 0; j < 16; ++j) { const unsigned c = xb_ld(&bar[XB_XCNT(j)]); sum += c; cnt += (c > 0u) ? 1u : 0u; mine = (j == x) ? c : mine; }
        if (sum == G) break;
        __builtin_amdgcn_s_sleep(1);
        if ((++sp & 255u) == 0u) { if (xb_ld(&bar[XB_TMO])) break; if (sp > XB_SPIN_CAP) { atomicAdd(&bar[XB_TMO], 1u); break; } }
    }
    nloc = mine > 0u ? mine : 1u; nx = cnt > 0u ? cnt : 1u;
}

__device__ __forceinline__ void xcd_barrier(const XcdBarrier& b) {
    asm volatile("s_waitcnt vmcnt(0)" ::: "memory");
    __syncthreads();
    if (threadIdx.x == 0) {
        unsigned* bar = b.bar;
        __builtin_amdgcn_s_waitcnt(0);
        unsigned nloc = b.st[0], nx = b.st[1];
        if (nloc == 0u) { xcd_barrier_complete(bar, b.x, nloc, nx); b.st[0] = nloc; b.st[1] = nx; }
        const unsigned old = xb_add(&bar[XB_XSUB(b.x)], 1u);
        const unsigned gen = old / nloc;
        if (old + 1u == (gen + 1u) * nloc) {
            __builtin_amdgcn_fence(__ATOMIC_RELEASE, "agent");
            asm volatile("s_waitcnt vmcnt(0)" ::: "memory");
            const unsigned og = xb_add(&bar[XB_TOP], 1u);
            const unsigned tg = og / nx;
            if (og + 1u == (tg + 1u) * nx) xb_add(&bar[XB_TOPGEN], 1u);
            else XB_SPIN(xb_ld(&bar[XB_TOPGEN]) == tg, bar);
            __builtin_amdgcn_fence(__ATOMIC_ACQUIRE, "agent");
            xb_add(&bar[XB_XGEN(b.x)], 1u);
            asm volatile("s_waitcnt vmcnt(0)" ::: "memory");
        } else {
            XB_SPIN(xb_ld(&bar[XB_XGEN(b.x)]) == gen, bar);
            __builtin_amdgcn_fence(__ATOMIC_ACQUIRE, "agent");
            asm volatile("s_waitcnt vmcnt(0)" ::: "memory");
        }
    }
    __syncthreads();
}


constexpr int LDS_COEF = 139264;
__device__ __forceinline__ float softplus_f(float x) { const float e = __expf(-fabsf(x)); const float l = (e < 1e-3f) ? e * (1.f - 0.5f * e) : __logf(1.f + e); return fmaxf(x, 0.f) + l; }
__device__ __forceinline__ void chunk_coeffs(float* cf, KAP a, int u, const bf16_t* projrow, int lane) {
    float lf0, lf1, lb0, lb1, df0, df1, db0, db1;
    if (u < 8) { const float lf = a->in[18][u], lb = a->in[18][8 + u]; lf0 = lf1 = lf; lb0 = lb1 = lb; df0 = df1 = db0 = db1 = 1.f; }
    else { const int hd = u - 8; const float Af = __expf(a->in[22][hd]), Ab = __expf(a->in[22][16 + hd]), bf = a->in[23][hd], bb = a->in[23][16 + hd];
        const float r0 = bf2f(projrow[(size_t)(2 * lane) * NPROJ + 6144 + hd]), r1 = bf2f(projrow[(size_t)(2 * lane + 1) * NPROJ + 6144 + hd]);
        df0 = softplus_f(r0 + bf); df1 = softplus_f(r1 + bf); db0 = softplus_f(r0 + bb); db1 = softplus_f(r1 + bb);
        lf0 = -df0 * Af; lf1 = -df1 * Af; lb0 = -db0 * Ab; lb1 = -db1 * Ab; }
    float pf = lf0 + lf1, pb = lb0 + lb1;
#pragma unroll
    for (int o = 1; o < 64; o <<= 1) { const float tf = shidx(pf, (lane - o) & 63), tb = shidx(pb, (lane - o) & 63); if (lane >= o) { pf += tf; pb += tb; } }
    const float totb = shidx(pb, 63);
    *(f32x2v*)(cf + 2 * lane) = (f32x2v){pf - lf1, pf};
    *(f32x2v*)(cf + 128 + 2 * lane) = (f32x2v){totb - (pb - lb1) + lb0, totb - pb + lb1};
    *(f32x2v*)(cf + 256 + 2 * lane) = (f32x2v){df0, df1}; *(f32x2v*)(cf + 384 + 2 * lane) = (f32x2v){db0, db1};
}
__device__ __forceinline__ void phase_coeffs(KAP a, int lane, int wave, int blk, int nblk) {
    const bf16_t* proj = (const bf16_t*)(a->ws + WS_PROJ); float* coef = (float*)(a->ws + WS_COEF);
    for (int task = blk * 8 + wave; task < 160 * 24; task += nblk * 8) { const int cl = task / 24, u = task % 24;
        chunk_coeffs(coef + (size_t)task * 512, a, u, proj + (size_t)cl * 128 * NPROJ, lane); }
}

#define TR_STORE8(dst_, w_) do { (dst_)[0] = (bf16_t)((w_).x & 0xffff); (dst_)[136] = (bf16_t)((w_).x >> 16); (dst_)[272] = (bf16_t)((w_).y & 0xffff); (dst_)[408] = (bf16_t)((w_).y >> 16); \
        (dst_)[544] = (bf16_t)((w_).z & 0xffff); (dst_)[680] = (bf16_t)((w_).z >> 16); (dst_)[816] = (bf16_t)((w_).w & 0xffff); (dst_)[952] = (bf16_t)((w_).w >> 16); } while (0)


typedef short v4i16_t __attribute__((ext_vector_type(4)));
__device__ __forceinline__ bf16x8 tr_frag(const LAS bf16_t* p, int ld4) {
    const v4i16_t lo = __builtin_amdgcn_ds_read_tr16_b64_v4i16((LAS v4i16_t*)p), hh = __builtin_amdgcn_ds_read_tr16_b64_v4i16((LAS v4i16_t*)(p + ld4));
    return (bf16x8){lo[0], lo[1], lo[2], lo[3], hh[0], hh[1], hh[2], hh[3]};
}
__device__ __forceinline__ const LAS bf16_t* tr_base(const LAS bf16_t* M, int ld, int c0, int lane) {
    return M + (8 * (lane >> 5) + ((lane & 15) >> 2)) * ld + c0 + 16 * ((lane >> 4) & 1) + 4 * (lane & 3);
}
template <int KT> __device__ __forceinline__ void mma_tile_tt(f32x16& acc, const LAS bf16_t* MA, int lda, int a0, const LAS bf16_t* MB, int ldb, int b0, int lane) {
    const LAS bf16_t* ap = tr_base(MA, lda, a0, lane); const LAS bf16_t* bp = tr_base(MB, ldb, b0, lane);
#pragma unroll 4
    for (int k = 0; k < KT; k += 16) { const bf16x8 a = tr_frag(ap + k * lda, 4 * lda), b = tr_frag(bp + k * ldb, 4 * ldb);
        acc = __builtin_amdgcn_mfma_f32_32x32x16_bf16(a, b, acc, 0, 0, 0); }
}
template <int KT> __device__ __forceinline__ void mma_tile_nt(f32x16& acc, const LAS bf16_t* A, int lda, const LAS bf16_t* MB, int ldb, int b0, int lane) {
    const LAS bf16_t* ap = A + (lane & 31) * lda + 8 * (lane >> 5); const LAS bf16_t* bp = tr_base(MB, ldb, b0, lane);
#pragma unroll 4
    for (int k = 0; k < KT; k += 16) { const bf16x8 a = *(const LAS bf16x8*)(ap + k); const bf16x8 b = tr_frag(bp + k * ldb, 4 * ldb);
        acc = __builtin_amdgcn_mfma_f32_32x32x16_bf16(a, b, acc, 0, 0, 0); }
}

template <int DK, int DV> struct P1Regs { u32x4 k[DK / 32]; u32x4 v[DV / 32]; float cfj[DK / 32], cbj[DK / 32], dfj[DK / 32], dbj[DK / 32], cl, cb0; };
template <int DK, int DV>
__device__ __forceinline__ void pass1_load(P1Regs<DK, DV>& R, const bf16_t* ksrc, int kld, const bf16_t* vsrc, int vld, const float* cf, int tid) {
#pragma unroll
    for (int it = 0; it < DK / 32; ++it) { const int g = tid + 512 * it, cgp = g % (DK / 8), j = g / (DK / 8);
        R.k[it] = *(const u32x4*)(ksrc + (size_t)j * kld + cgp * 8); R.cfj[it] = cf[j]; R.cbj[it] = cf[128 + j]; R.dfj[it] = cf[256 + j]; R.dbj[it] = cf[384 + j]; }
#pragma unroll
    for (int it = 0; it < DV / 32; ++it) { const int g = tid + 512 * it, cgp = g % (DV / 8), j = g / (DV / 8); R.v[it] = *(const u32x4*)(vsrc + (size_t)j * vld + cgp * 8); }
    R.cl = cf[127]; R.cb0 = cf[128];
}
template <int DK, int DV>
__device__ __forceinline__ void pass1_compute(const P1Regs<DK, DV>& R, LAS unsigned char* lds, float kscale, bf16_t* st_item, float* dec_item, int tid, int lane, int wave) {
    constexpr int LDV = (DV == 128) ? 160 : 96, LDK = 2 * DK + 32;
    LAS bf16_t* V = (LAS bf16_t*)lds; LAS bf16_t* KS = (LAS bf16_t*)(lds + 40960);
#pragma unroll
    for (int it = 0; it < DV / 32; ++it) { const int g = tid + 512 * it, cgp = g % (DV / 8), j = g / (DV / 8); *(LAS u32x4*)(V + j * LDV + cgp * 8) = R.v[it]; }
#pragma unroll
    for (int it = 0; it < DK / 32; ++it) { const int g = tid + 512 * it, cgp = g % (DK / 8), j = g / (DK / 8);
        const float wf = __expf(R.cl - R.cfj[it]) * R.dfj[it] * kscale, wb = __expf(R.cb0 - R.cbj[it]) * R.dbj[it] * kscale;
        float f[8]; UNPACK8(R.k[it], f);
        u32x4 a, b; a.x = pk2(f[0] * wf, f[1] * wf); a.y = pk2(f[2] * wf, f[3] * wf); a.z = pk2(f[4] * wf, f[5] * wf); a.w = pk2(f[6] * wf, f[7] * wf);
        b.x = pk2(f[0] * wb, f[1] * wb); b.y = pk2(f[2] * wb, f[3] * wb); b.z = pk2(f[4] * wb, f[5] * wb); b.w = pk2(f[6] * wb, f[7] * wb);
        *(LAS u32x4*)(KS + j * LDK + cgp * 8) = a; *(LAS u32x4*)(KS + j * LDK + DK + cgp * 8) = b; }
    if (tid == 0) { dec_item[0] = __expf(R.cl); dec_item[1] = __expf(R.cb0); }
}
template <int DK, int DV>
__device__ __forceinline__ void pass1_mma(LAS unsigned char* lds, bf16_t* st_item, int lane, int wave) {
    constexpr int LDV = (DV == 128) ? 160 : 96, LDK = 2 * DK + 32;
    LAS bf16_t* V = (LAS bf16_t*)lds; LAS bf16_t* KS = (LAS bf16_t*)(lds + 40960);
    constexpr int NTN = 2 * DK / 32;
#pragma unroll
    for (int q = 0; q < 2; ++q) { const int id = 2 * wave + q, mt = id / NTN, nt = id % NTN;
        f32x16 acc = {}; mma_tile_tt<128>(acc, V, LDV, 32 * mt, KS, LDK, 32 * nt, lane);
        const int hi = lane >> 5, dcol = 32 * nt + (lane & 31);
#pragma unroll
        for (int r = 0; r < 16; ++r) st_item[(size_t)(32 * mt + crow(r, hi)) * (2 * DK) + dcol] = f2bf1(acc[r]); }
}
template <int DK, int DV, bool RET>
__device__ __forceinline__ void pass1_run(KAP a, LAS unsigned char* lds, int tid, int lane, int wave, int blk, int nblk) {
    const bf16_t* proj = (const bf16_t*)(a->ws + WS_PROJ); const bf16_t* xbc = (const bf16_t*)(a->ws + WS_H); bf16_t* states = (bf16_t*)(a->ws + WS_STATES);
    float* dec = (float*)(a->ws + WS_DEC); const float* coef = (const float*)(a->ws + WS_COEF);
    constexpr int NU = RET ? 8 : 16, U0 = RET ? 0 : 8; const int total = 160 * NU;
    P1Regs<DK, DV> R;
#define P1_SRC(q_) const int cl_ = (q_) / NU, uu_ = (q_) % NU, it_ = cl_ * 24 + U0 + uu_; const size_t r0_ = (size_t)cl_ * 128; \
        const bf16_t* ks_ = RET ? proj + r0_ * NPROJ + 512 + uu_ * 64 : xbc + r0_ * 2048 + 1024 + (uu_ >> 2) * 128; const int kl_ = RET ? NPROJ : 2048; \
        const bf16_t* vs_ = RET ? proj + r0_ * NPROJ + 1024 + uu_ * 128 : xbc + r0_ * 2048 + uu_ * 64;
    int q = (nblk % 8 == 0) ? (blk % 8) * (nblk / 8) + blk / 8 : blk;
    if (q < total) { P1_SRC(q); pass1_load<DK, DV>(R, ks_, kl_, vs_, kl_, coef + (size_t)it_ * 512, tid); }
    for (; q < total; q += nblk) {
        const int cl = q / NU, uu = q % NU, it = cl * 24 + U0 + uu;
        __syncthreads();
        pass1_compute<DK, DV>(R, lds, RET ? 0.125f : 1.f, states + (size_t)it * 16384, dec + it * 2, tid, lane, wave);
        if (q + nblk < total) { P1_SRC(q + nblk); pass1_load<DK, DV>(R, ks_, kl_, vs_, kl_, coef + (size_t)it_ * 512, tid); }
        __syncthreads();
        pass1_mma<DK, DV>(lds, states + (size_t)it * 16384, lane, wave);
    }
    __syncthreads();
#undef P1_SRC
}
__device__ __forceinline__ void phase_pass1(KAP a, LAS unsigned char* lds, int tid, int lane, int wave, int blk, int nblk) {
    pass1_run<64, 128, true>(a, lds, tid, lane, wave, blk, nblk);
    pass1_run<128, 64, false>(a, lds, tid, lane, wave, blk, nblk);
}

template <int DK, int DV> struct P3Regs { u32x4 q[DK / 32]; u32x4 k[DK / 32]; u32x4 v[DV / 32]; u32x4 s[DV * 2 * DK / 4096]; f32x4 c; };
template <int DK, int DV>
__device__ __forceinline__ void pass3_load(P3Regs<DK, DV>& R, const bf16_t* qsrc, const bf16_t* ksrc, int kld, const bf16_t* vsrc, int vld, const bf16_t* st_item, const float* cf, int tid) {
    constexpr int NCG = DK / 8;
#pragma unroll
    for (int it = 0; it < DK / 32; ++it) { const int g = tid + 512 * it, cgp = g % NCG, j = g / NCG;
        R.q[it] = *(const u32x4*)(qsrc + (size_t)j * kld + cgp * 8); R.k[it] = *(const u32x4*)(ksrc + (size_t)j * kld + cgp * 8); }
#pragma unroll
    for (int it = 0; it < DV / 32; ++it) { const int g = tid + 512 * it, cgp = g % (DV / 8), j = g / (DV / 8); R.v[it] = *(const u32x4*)(vsrc + (size_t)j * vld + cgp * 8); }
#pragma unroll
    for (int it = 0; it < DV * 2 * DK / 4096; ++it) R.s[it] = *(const u32x4*)(st_item + (size_t)(tid + 512 * it) * 8);
    if (tid < 128) R.c = *(const f32x4*)(cf + tid * 4);
}
template <int DK, int DV>
__device__ __forceinline__ void pass3_stage(const P3Regs<DK, DV>& R, LAS unsigned char* lds, int tid) {
    constexpr int LQ = DK + 8, LS = 2 * DK + 8, NCG = DK / 8, NCS = 2 * DK / 8, LDV = (DV == 128) ? 160 : 96;
    constexpr int OKP = 128 * LQ * 2, OV = OKP + 34816, OST = OV + 128 * LDV * 2, OCF = 129024;
    LAS bf16_t* Q = (LAS bf16_t*)lds; LAS bf16_t* KP = (LAS bf16_t*)(lds + OKP); LAS bf16_t* V = (LAS bf16_t*)(lds + OV); LAS bf16_t* ST = (LAS bf16_t*)(lds + OST);
    LAS float* cf = (LAS float*)(lds + OCF);
#pragma unroll
    for (int it = 0; it < DK / 32; ++it) { const int g = tid + 512 * it, cgp = g % NCG, j = g / NCG;
        *(LAS u32x4*)(Q + j * LQ + cgp * 8) = R.q[it]; *(LAS u32x4*)(KP + j * LQ + cgp * 8) = R.k[it]; }
#pragma unroll
    for (int it = 0; it < DV / 32; ++it) { const int g = tid + 512 * it, cgp = g % (DV / 8), j = g / (DV / 8); *(LAS u32x4*)(V + j * LDV + cgp * 8) = R.v[it]; }
#pragma unroll
    for (int it = 0; it < DV * 2 * DK / 4096; ++it) { const int g = tid + 512 * it, cgp = g % NCS, vv = g / NCS; *(LAS u32x4*)(ST + vv * LS + cgp * 8) = R.s[it]; }
    if (tid < 128) *(LAS f32x4*)(cf + tid * 4) = R.c;
}
template <int DK, int DV>
__device__ __forceinline__ void pass3_compute(LAS unsigned char* lds, float kscale, float dsum, bf16_t* y0, bf16_t* y1, int yld, int lane, int wave, bool prefetch_sync) {
    constexpr int LQ = DK + 8, LS = 2 * DK + 8, LDV = (DV == 128) ? 160 : 96;
    constexpr int OKP = 128 * LQ * 2, OV = OKP + 34816, OST = OV + 128 * LDV * 2, OCF = 129024;
    LAS bf16_t* Q = (LAS bf16_t*)lds; LAS bf16_t* KP = (LAS bf16_t*)(lds + OKP); LAS bf16_t* V = (LAS bf16_t*)(lds + OV); LAS bf16_t* ST = (LAS bf16_t*)(lds + OST);
    LAS float* cf = (LAS float*)(lds + OCF);
    const int rb = wave >> 1, ch = wave & 1, hi = lane >> 5, l31 = lane & 31;
    f32x16 sc0 = {}, sc1 = {};
    mma_tile<DK>(sc0, Q + rb * 32 * LQ, LQ, KP + (64 * ch) * LQ, LQ, lane);
    mma_tile<DK>(sc1, Q + rb * 32 * LQ, LQ, KP + (64 * ch + 32) * LQ, LQ, lane);
    __syncthreads();
    {
        const int j0 = 64 * ch + l31, j1 = j0 + 32;
        const float cfj0 = cf[j0], cbj0 = cf[128 + j0], dfj0 = cf[256 + j0] * kscale, dbj0 = cf[384 + j0] * kscale;
        const float cfj1 = cf[j1], cbj1 = cf[128 + j1], dfj1 = cf[256 + j1] * kscale, dbj1 = cf[384 + j1] * kscale;
        const bool F0 = rb >= 2 * ch, B0 = rb <= 2 * ch, F1 = rb >= 2 * ch + 1, B1 = rb <= 2 * ch + 1;
#pragma unroll
        for (int r = 0; r < 16; ++r) { const int i = 32 * rb + crow(r, hi); const float cfi = cf[i], cbi = cf[128 + i];
            float f0 = 0.f, f1 = 0.f;
            if (F0) f0 = (i >= j0 ? __expf(fminf(cfi - cfj0, 0.f)) * dfj0 : 0.f);
            if (B0) f0 += (j0 >= i ? __expf(fminf(cbi - cbj0, 0.f)) * dbj0 : 0.f);
            if (F1) f1 = (i >= j1 ? __expf(fminf(cfi - cfj1, 0.f)) * dfj1 : 0.f);
            if (B1) f1 += (j1 >= i ? __expf(fminf(cbi - cbj1, 0.f)) * dbj1 : 0.f);
            KP[i * 136 + j0] = f2bf1(sc0[r] * f0); KP[i * 136 + j1] = f2bf1(sc1[r] * f1); }
    }
    __syncthreads();
#pragma nounroll
    for (int t = 0; t < DV / 64; ++t) { const int colbase = ch * (DV / 2) + 32 * t;
        f32x16 aP = {}, aF = {}, aB = {};
        mma_tile_nt<128>(aP, KP + rb * 32 * 136, 136, V, LDV, colbase, lane);
        __builtin_amdgcn_sched_barrier(0);
        mma_tile<DK>(aF, Q + rb * 32 * LQ, LQ, ST + colbase * LS, LS, lane);
        __builtin_amdgcn_sched_barrier(0);
        mma_tile<DK>(aB, Q + rb * 32 * LQ, LQ, ST + colbase * LS + DK, LS, lane);
        __builtin_amdgcn_sched_barrier(0);
        const int vv = colbase + l31;
        bf16_t* yp = (vv < 64) ? y0 + vv : y1 + (vv - 64);
#pragma unroll
        for (int r = 0; r < 16; ++r) { const int i = 32 * rb + crow(r, hi);
            float y = aP[r] + __expf(cf[i]) * aF[r] + __expf(cf[128 + i]) * aB[r];
            if (dsum != 0.f) y += dsum * bf2f(V[i * LDV + vv]);
            yp[(size_t)i * yld] = f2bf1(y); } }
}
template <int DK, int DV, bool RET>
__device__ __forceinline__ void pass3_run(KAP a, LAS unsigned char* lds, int tid, int lane, int wave, int blk, int nblk, bool dummy) {
    bf16_t* proj = (bf16_t*)(a->ws + WS_PROJ); bf16_t* xbc = (bf16_t*)(a->ws + WS_H); const bf16_t* states = (const bf16_t*)(a->ws + WS_STATES);
    const float* coef = (const float*)(a->ws + WS_COEF);
    constexpr int NU = RET ? 8 : 16, U0 = RET ? 0 : 8; const int total = 160 * NU;
    P3Regs<DK, DV> R;
#define P3_SRC(q_) const int cl_ = (q_) / NU, uu_ = (q_) % NU, it_ = cl_ * 24 + U0 + uu_; const size_t r0_ = (size_t)cl_ * 128; \
        bf16_t* qs_ = RET ? proj + r0_ * NPROJ + uu_ * 64 : xbc + r0_ * 2048 + 1536 + (uu_ >> 2) * 128; \
        bf16_t* ks_ = RET ? proj + r0_ * NPROJ + 512 + uu_ * 64 : xbc + r0_ * 2048 + 1024 + (uu_ >> 2) * 128; const int kl_ = RET ? NPROJ : 2048; \
        bf16_t* vs_ = RET ? proj + r0_ * NPROJ + 1024 + uu_ * 128 : xbc + r0_ * 2048 + uu_ * 64;
    int q = (nblk % 8 == 0) ? (blk % 8) * (nblk / 8) + blk / 8 : blk;
    if (q < total) { P3_SRC(q); pass3_load<DK, DV>(R, qs_, ks_, kl_, vs_, kl_, states + (size_t)it_ * 16384, coef + (size_t)it_ * 512, tid); }
    for (; q < total; q += nblk) {
        P3_SRC(q);
        __syncthreads();
        pass3_stage<DK, DV>(R, lds, tid);
        if (q + nblk < total) { const int qn = q + nblk; const int cl2 = qn / NU, uu2 = qn % NU, it2 = cl2 * 24 + U0 + uu2; const size_t r02 = (size_t)cl2 * 128;
            const bf16_t* qs2 = RET ? proj + r02 * NPROJ + uu2 * 64 : xbc + r02 * 2048 + 1536 + (uu2 >> 2) * 128;
            const bf16_t* ks2 = RET ? proj + r02 * NPROJ + 512 + uu2 * 64 : xbc + r02 * 2048 + 1024 + (uu2 >> 2) * 128;
            const bf16_t* vs2 = RET ? proj + r02 * NPROJ + 1024 + uu2 * 128 : xbc + r02 * 2048 + uu2 * 64;
            pass3_load<DK, DV>(R, qs2, ks2, kl_, vs2, kl_, states + (size_t)it2 * 16384, coef + (size_t)it2 * 512, tid); }
        __syncthreads();
        const float dsum = RET ? 0.f : a->in[24][uu_] + a->in[24][16 + uu_];
        bf16_t* dm_ = (bf16_t*)(a->out + (size_t)HROWS * DM) + r0_ * 2048;
        if (dummy) pass3_compute<DK, DV>(lds, RET ? 0.125f : 1.f, dsum, RET ? dm_ + uu_ * 64 : dm_ + 1024 + uu_ * 64, RET ? dm_ + 512 + uu_ * 64 : dm_ + 1024 + uu_ * 64, 2048, lane, wave, true);
        else pass3_compute<DK, DV>(lds, RET ? 0.125f : 1.f, dsum, RET ? qs_ : vs_, RET ? ks_ : vs_, kl_, lane, wave, true);
    }
    __syncthreads();
#undef P3_SRC
}
__device__ __forceinline__ void phase_pass3(KAP a, LAS unsigned char* lds, int tid, int lane, int wave, int blk, int nblk, bool dummy) {
    pass3_run<64, 128, true>(a, lds, tid, lane, wave, blk, nblk, dummy);
    pass3_run<128, 64, false>(a, lds, tid, lane, wave, blk, nblk, dummy);
}
__device__ __forceinline__ void p2_decode(int eg, int u, int b, int& elem, int& dir, size_t& sidx, int& sstride) {
    int vv, dcol, d0;
    if (u < 8) { vv = eg >> 4; dcol = (eg & 15) * 8; dir = dcol >> 6; d0 = dcol & 63; sidx = ((((size_t)b * 2 + dir) * 8 + u) * 64 + d0) * 128 + vv; sstride = 128; elem = vv * 128 + dcol; }
    else { vv = eg >> 5; dcol = (eg & 31) * 8; dir = dcol >> 7; d0 = dcol & 127; sidx = ((((size_t)b * 2 + dir) * 16 + (u - 8)) * 128 + d0) * 64 + vv; sstride = 64; elem = vv * 256 + dcol; }
}
#define PK8(o_, r_) do { (o_).x = pk2(r_[0], r_[1]); (o_).y = pk2(r_[2], r_[3]); (o_).z = pk2(r_[4], r_[5]); (o_).w = pk2(r_[6], r_[7]); } while (0)
__device__ __forceinline__ void phase_pass2(KAP a, int half, int tid, int blk, int nblk) {
    bf16_t* states = (bf16_t*)(a->ws + WS_STATES); const float* dec = (const float*)(a->ws + WS_DEC);
    const int T = nblk * 512, t0 = blk * 512 + tid;
    if (half == 0) {
        const int total = 32 * 24 * 2048;
        for (int base = t0; base < total; base += 4 * T) {
            u32x4 wa[4], wb[4]; float Aa[4], Ab[4]; bf16_t* pa[4]; bf16_t* pb[4]; size_t sidx[4]; int sstr[4]; bool ok[4]; int uu[4];
#pragma unroll
            for (int g = 0; g < 4; ++g) { const int gid = base + g * T; ok[g] = gid < total; const int gg = ok[g] ? gid : t0;
                const int eg = gg & 2047, t = gg >> 11, u = t % 24, b = t / 24; int elem, dir; p2_decode(eg, u, b, elem, dir, sidx[g], sstr[g]); uu[g] = u;
                const int ca = dir ? 1 : 0, cb = 1 - ca; const int ia = (2 * b + ca) * 24 + u, ib = (2 * b + cb) * 24 + u;
                pa[g] = states + (size_t)ia * 16384 + elem; pb[g] = states + (size_t)ib * 16384 + elem;
                wa[g] = *(const u32x4*)pa[g]; wb[g] = *(const u32x4*)pb[g]; Aa[g] = dec[ia * 2 + dir]; Ab[g] = dec[ib * 2 + dir]; }
#pragma unroll
            for (int g = 0; g < 4; ++g) { if (ok[g]) { float fa[8], fb[8], run[8]; UNPACK8(wa[g], fa); UNPACK8(wb[g], fb);
                { unsigned z0 = 0u; asm volatile("" : "+v"(z0)); *(u32x4*)pa[g] = (u32x4){z0, z0, z0, z0}; }
                u32x4 o; PK8(o, fa); *(u32x4*)pb[g] = o;
#pragma unroll
                for (int e = 0; e < 8; ++e) run[e] = Ab[g] * fa[e] + fb[e];
                float* op = a->out + (uu[g] < 8 ? OUT_SRET : OUT_SSSM) + sidx[g];
#pragma unroll
                for (int e = 0; e < 8; ++e) op[(size_t)e * sstr[g]] = run[e]; } }
        }
    }
    {
        const int nsamp = half == 0 ? 3 : 5, b0 = half == 0 ? 0 : 3, cbase = half == 0 ? 64 : 0; const int total = nsamp * 24 * 2048;
        for (int gid = t0; gid < total; gid += T) {
            const int eg = gid & 2047, t = gid >> 11, u = t % 24, s = t / 24, b = b0 + s, c0 = cbase + 32 * s;
            int elem, dir, sstride; size_t sidx; p2_decode(eg, u, b, elem, dir, sidx, sstride);
            float run[8]; { const float* sp = (u < 8 ? a->in[2] : a->in[3]) + sidx;
#pragma unroll
                for (int e = 0; e < 8; ++e) run[e] = sp[(size_t)e * sstride]; }
            bf16_t* pbase = states + (size_t)u * 16384 + elem; const float* dbase = dec + u * 2 + dir;
            const int cstart = dir ? c0 + 31 : c0, cstep = dir ? -1 : 1;
            u32x4 w0[8], w1[8]; float A0[8], A1[8];
#pragma unroll
            for (int i = 0; i < 8; ++i) { const int c = cstart + cstep * i; w0[i] = *(const u32x4*)(pbase + (size_t)c * 24 * 16384); A0[i] = dbase[c * 48]; }
#pragma unroll
            for (int bt = 0; bt < 4; ++bt) {
                if (bt < 3) {
#pragma unroll
                    for (int i = 0; i < 8; ++i) { const int c = cstart + cstep * (8 * (bt + 1) + i);
                        if (bt & 1) { w0[i] = *(const u32x4*)(pbase + (size_t)c * 24 * 16384); A0[i] = dbase[c * 48]; } else { w1[i] = *(const u32x4*)(pbase + (size_t)c * 24 * 16384); A1[i] = dbase[c * 48]; } } }
#pragma unroll
                for (int i = 0; i < 8; ++i) { const int c = cstart + cstep * (8 * bt + i); float f[8];
                    if (bt & 1) { UNPACK8(w1[i], f); } else { UNPACK8(w0[i], f); }
                    const float A = (bt & 1) ? A1[i] : A0[i];
                    u32x4 o; PK8(o, run); *(u32x4*)(pbase + (size_t)c * 24 * 16384) = o;
#pragma unroll
                    for (int e = 0; e < 8; ++e) run[e] = A * run[e] + f[e]; }
            }
        }
    }
}

__device__ __forceinline__ void phase_gate(KAP a, int lane, int wave, int blk, int nblk) {
    const bf16_t* proj = (const bf16_t*)(a->ws + WS_PROJ); const bf16_t* xbc = (const bf16_t*)(a->ws + WS_H); bf16_t* yg = (bf16_t*)(a->ws + WS_YG);
    for (int rr = blk * 8 + wave; rr < HROWS; rr += nblk * 8) {
        const bf16_t* prow = proj + (size_t)rr * NPROJ; bf16_t* orow = yg + (size_t)rr * 2048;
        {   const int h = lane >> 3, vv0 = (lane & 7) * 16; const int col = vv0 < 64 ? h * 64 + vv0 : 512 + h * 64 + vv0 - 64;
            float y[16], g[16];
            { const u32x4 w0 = *(const u32x4*)(prow + col), w1 = *(const u32x4*)(prow + col + 8); float t0[8], t1[8]; UNPACK8(w0, t0); UNPACK8(w1, t1);
#pragma unroll
              for (int e = 0; e < 8; ++e) { y[e] = t0[e]; y[8 + e] = t1[e]; } }
            { const u32x4 w0 = *(const u32x4*)(prow + 2048 + h * 128 + vv0), w1 = *(const u32x4*)(prow + 2048 + h * 128 + vv0 + 8); float t0[8], t1[8]; UNPACK8(w0, t0); UNPACK8(w1, t1);
#pragma unroll
              for (int e = 0; e < 8; ++e) { g[e] = t0[e]; g[8 + e] = t1[e]; } }
            float s = 0.f;
#pragma unroll
            for (int e = 0; e < 16; ++e) s += y[e];
            s += shx(s, 1, lane); s += shx(s, 2, lane); s += shx(s, 4, lane);
            const float mean = s * (1.f / 128.f); float q = 0.f;
#pragma unroll
            for (int e = 0; e < 16; ++e) { y[e] -= mean; q += y[e] * y[e]; }
            q += shx(q, 1, lane); q += shx(q, 2, lane); q += shx(q, 4, lane);
            const float rstd = 1.0f / sqrtf(q * (1.f / 128.f) + 1e-6f);
            const float* gn = a->in[19] + h * 128 + vv0; float o[16];
#pragma unroll
            for (int e = 0; e < 16; ++e) o[e] = silu_f(g[e]) * (y[e] * rstd * gn[e]);
            u32x4 w0, w1; w0.x = pk2(o[0], o[1]); w0.y = pk2(o[2], o[3]); w0.z = pk2(o[4], o[5]); w0.w = pk2(o[6], o[7]);
            w1.x = pk2(o[8], o[9]); w1.y = pk2(o[10], o[11]); w1.z = pk2(o[12], o[13]); w1.w = pk2(o[14], o[15]);
            *(u32x4*)(orow + h * 128 + vv0) = w0; *(u32x4*)(orow + h * 128 + vv0 + 8) = w1; }
        {   const bf16_t* xr = xbc + (size_t)rr * 2048 + lane * 16; const bf16_t* zr = prow + 3072 + lane * 16;
            float y[16], z[16];
            { const u32x4 w0 = *(const u32x4*)(xr), w1 = *(const u32x4*)(xr + 8); float t0[8], t1[8]; UNPACK8(w0, t0); UNPACK8(w1, t1);
#pragma unroll
              for (int e = 0; e < 8; ++e) { y[e] = t0[e]; y[8 + e] = t1[e]; } }
            { const u32x4 w0 = *(const u32x4*)(zr), w1 = *(const u32x4*)(zr + 8); float t0[8], t1[8]; UNPACK8(w0, t0); UNPACK8(w1, t1);
#pragma unroll
              for (int e = 0; e < 8; ++e) { z[e] = t0[e]; z[8 + e] = t1[e]; } }
            float ss = 0.f;
#pragma unroll
            for (int e = 0; e < 16; ++e) { y[e] = y[e] * silu_f(z[e]); ss += y[e] * y[e]; }
            const float rstd = 1.0f / sqrtf(wave_sum(ss, lane) * (1.f / 1024.f) + 1e-6f);
            const float* ng = a->in[25] + lane * 16; float o[16];
#pragma unroll
            for (int e = 0; e < 16; ++e) o[e] = y[e] * rstd * ng[e];
            u32x4 w0, w1; w0.x = pk2(o[0], o[1]); w0.y = pk2(o[2], o[3]); w0.z = pk2(o[4], o[5]); w0.w = pk2(o[6], o[7]);
            w1.x = pk2(o[8], o[9]); w1.y = pk2(o[10], o[11]); w1.z = pk2(o[12], o[13]); w1.w = pk2(o[14], o[15]);
            *(u32x4*)(orow + 1024 + lane * 16) = w0; *(u32x4*)(orow + 1024 + lane * 16 + 8) = w1; }
    }
}

constexpr float ATT_C2 = 0.125f * 1.4426950408889634f;
__device__ __forceinline__ void phase_attn_prep(KAP a, LAS unsigned char* lds, int tid, int lane, int wave, int blk, int nblk) {
    bf16_t* qkv = (bf16_t*)(a->ws + WS_QKV); bf16_t* kcat = (bf16_t*)(a->ws + WS_KCAT); bf16_t* vcat = (bf16_t*)(a->ws + WS_VCAT); bf16_t* kp = (bf16_t*)(a->ws + WS_KP); bf16_t* vp = (bf16_t*)(a->ws + WS_VP);
    LAS bf16_t* vt = (LAS bf16_t*)lds;
    const int d0 = (lane & 3) * 16, sub = lane & 3;
    for (int unit = blk; unit < MROWS / 64; unit += nblk) {
        const int r0 = unit * 64; const bool smp = r0 >= PROWS; int b, t0; if (smp) { b = (r0 - PROWS) >> 12; t0 = (r0 - PROWS) & 4095; } else { b = r0 >> 8; t0 = r0 & 255; }
        for (int rl = 0; rl < 8; ++rl) {
            const int row = r0 + 8 * wave + rl, t = t0 + 8 * wave + rl; bf16_t* qrow = qkv + (size_t)row * NQKV;
            float cs[16], sn[16];
            if (smp) { const float posv = (sub >> 1) ? (float)(t & 63) : (float)(t >> 6);
#pragma unroll
                for (int e = 0; e < 16; ++e) { const float ang = posv * exp2f(-0.83048202f * (float)e); const float rev = ang * 0.15915494309f; cs[e] = __builtin_amdgcn_cosf(rev); sn[e] = __builtin_amdgcn_sinf(rev); } }
            {
                float f[16]; { const u32x4 w0 = *(const u32x4*)(qrow + lane * 16), w1 = *(const u32x4*)(qrow + lane * 16 + 8); float t0_[8], t1_[8]; UNPACK8(w0, t0_); UNPACK8(w1, t1_);
#pragma unroll
                    for (int e = 0; e < 8; ++e) { f[e] = t0_[e]; f[8 + e] = t1_[e]; } }
                float ss = 0.f;
#pragma unroll
                for (int e = 0; e < 16; ++e) ss += f[e] * f[e];
                ss += shx(ss, 1, lane); ss += shx(ss, 2, lane);
                const float rstd = 1.0f / sqrtf(ss * (1.f / 64.f) + 1e-6f);
#pragma unroll
                for (int e = 0; e < 16; ++e) f[e] = f[e] * rstd * a->in[27][d0 + e];
                if (smp) {
#pragma unroll
                    for (int e = 0; e < 16; ++e) { const float o = shx(f[e], 1, lane); f[e] = (sub & 1) ? (o * sn[e] + f[e] * cs[e]) : (f[e] * cs[e] - o * sn[e]); } }
                u32x4 w0, w1; w0.x = pk2(f[0] * ATT_C2, f[1] * ATT_C2); w0.y = pk2(f[2] * ATT_C2, f[3] * ATT_C2); w0.z = pk2(f[4] * ATT_C2, f[5] * ATT_C2); w0.w = pk2(f[6] * ATT_C2, f[7] * ATT_C2);
                w1.x = pk2(f[8] * ATT_C2, f[9] * ATT_C2); w1.y = pk2(f[10] * ATT_C2, f[11] * ATT_C2); w1.z = pk2(f[12] * ATT_C2, f[13] * ATT_C2); w1.w = pk2(f[14] * ATT_C2, f[15] * ATT_C2);
                *(u32x4*)(qrow + lane * 16) = w0; *(u32x4*)(qrow + lane * 16 + 8) = w1; }
            {
                const int l5 = lane & 31; float f[16]; u32x4 w0, w1;
                { w0 = *(const u32x4*)(qrow + 1024 + l5 * 16); w1 = *(const u32x4*)(qrow + 1024 + l5 * 16 + 8); float t0_[8], t1_[8]; UNPACK8(w0, t0_); UNPACK8(w1, t1_);
#pragma unroll
                    for (int e = 0; e < 8; ++e) { f[e] = t0_[e]; f[8 + e] = t1_[e]; } }
                float ss = 0.f;
#pragma unroll
                for (int e = 0; e < 16; ++e) ss += f[e] * f[e];
                ss += shx(ss, 1, lane); ss += shx(ss, 2, lane);
                const float rstd = 1.0f / sqrtf(ss * (1.f / 64.f) + 1e-6f);
                float kf[16];
#pragma unroll
                for (int e = 0; e < 16; ++e) kf[e] = f[e] * rstd * a->in[28][d0 + e];
                float kr[16];
#pragma unroll
                for (int e = 0; e < 16; ++e) { const float o = shx(kf[e], 1, lane); kr[e] = smp ? ((sub & 1) ? (o * sn[e] + kf[e] * cs[e]) : (kf[e] * cs[e] - o * sn[e])) : kf[e]; }
                if (lane < 16) { const int kvh = lane >> 2;
                    if (!smp) { float* ok = a->out + OUT_CK + (size_t)row * 256 + lane * 16;
#pragma unroll
                        for (int e = 0; e < 16; e += 4) *(f32x4*)(ok + e) = (f32x4){kf[e], kf[e + 1], kf[e + 2], kf[e + 3]}; }
                    bf16_t* kd = smp ? kcat + ((size_t)(b * 4 + kvh) * LKEYS + 256 + t) * 64 + d0 : kp + ((size_t)(b * 4 + kvh) * 256 + t) * 64 + d0;
                    u32x4 o0, o1; o0.x = pk2(kr[0], kr[1]); o0.y = pk2(kr[2], kr[3]); o0.z = pk2(kr[4], kr[5]); o0.w = pk2(kr[6], kr[7]);
                    o1.x = pk2(kr[8], kr[9]); o1.y = pk2(kr[10], kr[11]); o1.z = pk2(kr[12], kr[13]); o1.w = pk2(kr[14], kr[15]);
                    *(u32x4*)kd = o0; *(u32x4*)(kd + 8) = o1; }
                else if (lane < 32) { const int vl = lane - 16;
                    if (!smp) { float* ov = a->out + OUT_CV + (size_t)row * 256 + vl * 16;
#pragma unroll
                        for (int e = 0; e < 16; e += 4) *(f32x4*)(ov + e) = (f32x4){f[e], f[e + 1], f[e + 2], f[e + 3]}; }
                    LAS bf16_t* vd = vt + (8 * wave + rl) * 264 + vl * 16; *(LAS u32x4*)vd = w0; *(LAS u32x4*)(vd + 8) = w1; } }
        }
        __syncthreads();
        {   const int p = tid >> 1, hf = tid & 1, kvh = p >> 6, d = p & 63; unsigned w[16];
#pragma unroll
            for (int i = 0; i < 16; ++i) { const int o0 = 2 * i, k0 = 16 * (o0 >> 4) + ((o0 & 3) | ((o0 & 4) << 1) | ((o0 & 8) >> 1));
                w[i] = (unsigned)vt[(32 * hf + k0) * 264 + p] | ((unsigned)vt[(32 * hf + k0 + 1) * 264 + p] << 16); }
            bf16_t* vd = smp ? vcat + ((size_t)(b * 4 + kvh) * 64 + d) * LKEYS + 256 + t0 + 32 * hf : vp + ((size_t)(b * 4 + kvh) * 64 + d) * 256 + t0 + 32 * hf;
#pragma unroll
            for (int i = 0; i < 4; ++i) *(u32x4*)(vd + 8 * i) = (u32x4){w[4 * i], w[4 * i + 1], w[4 * i + 2], w[4 * i + 3]}; }
        __syncthreads();
    }
    for (int i = blk * 512 + tid; i < 8 * 4 * 256 * 64; i += nblk * 512) {
        { const int d = i & 63, key = (i >> 6) & 255, kvh = (i >> 14) & 3, b = i >> 16;
          kcat[((size_t)(b * 4 + kvh) * LKEYS + key) * 64 + d] = f2bf1(a->in[4][((size_t)(b * 256 + key) * 4 + kvh) * 64 + d]); }
        { const int pos = i & 255, d = (i >> 8) & 63, kvh = (i >> 14) & 3, b = i >> 16; const int key = (pos & ~15) + ((pos & 3) | ((pos & 4) << 1) | ((pos & 8) >> 1));
          vcat[((size_t)(b * 4 + kvh) * 64 + d) * LKEYS + pos] = f2bf1(a->in[5][((size_t)(b * 256 + key) * 4 + kvh) * 64 + d]); }
    }
}

#define MX3(a_, b_, c_) __builtin_fmaxf(__builtin_fmaxf((a_), (b_)), (c_))
constexpr int ATT_BUF = 18432, ATT_VOFF = 9216, ATT_QOFF = 3 * ATT_BUF;
__device__ __forceinline__ void phase_attn(KAP a, LAS unsigned char* lds, int tid, int lane, int wave, int blk, int nblk) {
    const bf16_t* qkv = (const bf16_t*)(a->ws + WS_QKV); bf16_t* O = (bf16_t*)(a->ws + WS_O);
    const int vcu = (nblk % 8 == 0) ? (blk % 8) * (nblk / 8) + blk / 8 : blk;
    const int hi = lane >> 5, l31 = lane & 31, lrow = tid >> 3, lch = (tid & 7) * 8;
    constexpr float THR = 6.0f;
    for (int u = vcu; u < 1280; u += nblk) {
        const bf16_t* kb; const bf16_t* vb; int vld, nkeys, qrow0, kvh;
        if (u < 1024) { const int b = u >> 7; kvh = (u >> 5) & 3; const int qb = u & 31; kb = (const bf16_t*)(a->ws + WS_KCAT) + (size_t)(b * 4 + kvh) * LKEYS * 64;
            vb = (const bf16_t*)(a->ws + WS_VCAT) + (size_t)(b * 4 + kvh) * 64 * LKEYS; vld = LKEYS; nkeys = LKEYS; qrow0 = PROWS + b * 4096 + qb * 128; }
        else { const int u2 = u - 1024, b = u2 >> 3; kvh = (u2 >> 1) & 3; const int qb = u2 & 1; kb = (const bf16_t*)(a->ws + WS_KP) + (size_t)(b * 4 + kvh) * 256 * 64;
            vb = (const bf16_t*)(a->ws + WS_VP) + (size_t)(b * 4 + kvh) * 64 * 256; vld = 256; nkeys = 256; qrow0 = b * 256 + qb * 128; }
        const int head = kvh * 4 + (wave & 3); const int qrow = qrow0 + 64 * (wave >> 2) + l31;
        LAS bf16x8* Qs = (LAS bf16x8*)(lds + ATT_QOFF) + wave * 512 + lane;
#pragma unroll
        for (int dd = 0; dd < 4; ++dd) { Qs[dd * 64] = *(const bf16x8*)(qkv + (size_t)qrow * NQKV + head * 64 + 16 * dd + 8 * hi);
            Qs[(4 + dd) * 64] = *(const bf16x8*)(qkv + (size_t)(qrow + 32) * NQKV + head * 64 + 16 * dd + 8 * hi); }
        f32x16 oA0 = {}, oA1 = {}, oB0 = {}, oB1 = {}; f32x16 ngA = {}; float mA = 0.f, lA = 0.f, lB = 0.f;
        const int NTL = nkeys / 64;
        const bf16_t* kg = kb + (size_t)lrow * 64 + lch; const bf16_t* vg = vb + (size_t)lrow * vld + lch;
        u32x4 kreg = *(const u32x4*)kg, vreg = *(const u32x4*)vg;
        __syncthreads();
        *(LAS u32x4*)((LAS bf16_t*)lds + lrow * 72 + lch) = kreg; *(LAS u32x4*)((LAS bf16_t*)(lds + ATT_VOFF) + lrow * 72 + lch) = vreg;
        kreg = *(const u32x4*)(kg + 64 * 64); vreg = *(const u32x4*)(vg + 64);
        __syncthreads();
#define ATT_S(Kt_) do { pA0 = ngA; pA1 = ngA; pB0 = ngA; pB1 = ngA; __builtin_amdgcn_s_setprio(1); \
            _Pragma("unroll") for (int dd = 0; dd < 4; ++dd) { \
                const bf16x8 k0 = *(const LAS bf16x8*)((Kt_) + l31 * 72 + 16 * dd + 8 * hi), k1 = *(const LAS bf16x8*)((Kt_) + (32 + l31) * 72 + 16 * dd + 8 * hi); \
                const bf16x8 qa = Qs[dd * 64], qb2 = Qs[(4 + dd) * 64]; \
                pA0 = __builtin_amdgcn_mfma_f32_32x32x16_bf16(k0, qa, pA0, 0, 0, 0); pA1 = __builtin_amdgcn_mfma_f32_32x32x16_bf16(k1, qa, pA1, 0, 0, 0); \
                pB0 = __builtin_amdgcn_mfma_f32_32x32x16_bf16(k0, qb2, pB0, 0, 0, 0); pB1 = __builtin_amdgcn_mfma_f32_32x32x16_bf16(k1, qb2, pB1, 0, 0, 0); \
                __builtin_amdgcn_sched_barrier(0); } __builtin_amdgcn_s_setprio(0); } while (0)
#define ATT_EXP(p0_, p1_, l_, pk_) do { float ls0 = 0.f, ls1 = 0.f; \
            _Pragma("unroll") for (int r = 0; r < 16; ++r) { p0_[r] = __builtin_amdgcn_exp2f(p0_[r]); p1_[r] = __builtin_amdgcn_exp2f(p1_[r]); ls0 += p0_[r]; ls1 += p1_[r]; } \
            l_ += ls0 + ls1; \
            pk_[0] = (u32x4){pk2(p0_[0], p0_[1]), pk2(p0_[2], p0_[3]), pk2(p0_[4], p0_[5]), pk2(p0_[6], p0_[7])}; \
            pk_[1] = (u32x4){pk2(p0_[8], p0_[9]), pk2(p0_[10], p0_[11]), pk2(p0_[12], p0_[13]), pk2(p0_[14], p0_[15])}; \
            pk_[2] = (u32x4){pk2(p1_[0], p1_[1]), pk2(p1_[2], p1_[3]), pk2(p1_[4], p1_[5]), pk2(p1_[6], p1_[7])}; \
            pk_[3] = (u32x4){pk2(p1_[8], p1_[9]), pk2(p1_[10], p1_[11]), pk2(p1_[12], p1_[13]), pk2(p1_[14], p1_[15])}; } while (0)
#define ATT_SM(first_) do { \
            float ma = MX3(pA0[0], pA1[0], pB0[0]), mb = MX3(pB1[0], pA0[1], pA1[1]); \
            _Pragma("unroll") for (int r = 1; r < 16; ++r) { ma = MX3(ma, pA0[r], pA1[r]); mb = MX3(mb, pB0[r], pB1[r]); } \
            float rm = __builtin_fmaxf(ma, mb); rm = __builtin_fmaxf(rm, shx(rm, 32, lane)); \
            if (__any(rm > THR || rm < -20.f)) { const float dl = __builtin_fmaxf(rm, -60.f); mA += dl; \
                _Pragma("unroll") for (int r = 0; r < 16; ++r) { pA0[r] -= dl; pA1[r] -= dl; pB0[r] -= dl; pB1[r] -= dl; ngA[r] = -mA; } \
                const float f = __builtin_amdgcn_exp2f(-dl); lA *= f; lB *= f; \
                _Pragma("unroll") for (int r = 0; r < 16; ++r) { oA0[r] *= f; oA1[r] *= f; oB0[r] *= f; oB1[r] *= f; } } \
            ATT_EXP(pA0, pA1, lA, pkA); __builtin_amdgcn_sched_barrier(0); ATT_EXP(pB0, pB1, lB, pkB); __builtin_amdgcn_sched_barrier(0); } while (0)
#define ATT_PV(Vt_) do { __builtin_amdgcn_s_setprio(1); _Pragma("unroll") for (int s = 0; s < 4; ++s) { \
                const bf16x8 v0 = *(const LAS bf16x8*)((Vt_) + l31 * 72 + 16 * s + 8 * hi), v1 = *(const LAS bf16x8*)((Vt_) + (32 + l31) * 72 + 16 * s + 8 * hi); \
                const bf16x8 fa = __builtin_bit_cast(bf16x8, pkA[s]), fb = __builtin_bit_cast(bf16x8, pkB[s]); \
                oA0 = __builtin_amdgcn_mfma_f32_32x32x16_bf16(v0, fa, oA0, 0, 0, 0); oA1 = __builtin_amdgcn_mfma_f32_32x32x16_bf16(v1, fa, oA1, 0, 0, 0); \
                oB0 = __builtin_amdgcn_mfma_f32_32x32x16_bf16(v0, fb, oB0, 0, 0, 0); oB1 = __builtin_amdgcn_mfma_f32_32x32x16_bf16(v1, fb, oB1, 0, 0, 0); \
                __builtin_amdgcn_sched_barrier(0); } __builtin_amdgcn_s_setprio(0); } while (0)
#define ATT_STAGE(t_) do { if ((t_) + 1 < NTL) { LAS bf16_t* Kn = (LAS bf16_t*)(lds + slot_next * ATT_BUF); \
                *(LAS u32x4*)(Kn + lrow * 72 + lch) = kreg; *(LAS u32x4*)(Kn + 4608 + lrow * 72 + lch) = vreg; \
                if ((t_) + 2 < NTL) { kreg = *(const u32x4*)(kg + (size_t)((t_) + 2) * 64 * 64); vreg = *(const u32x4*)(vg + ((t_) + 2) * 64); } } } while (0)
        if (wave < 4) {
            int slot = 0;
#pragma nounroll
            for (int t = 0; t <= NTL; ++t) {
                const int slot_next = (slot == 2) ? 0 : slot + 1;
                ATT_STAGE(t);
                if (t < NTL) { LAS bf16_t* Kt = (LAS bf16_t*)(lds + slot * ATT_BUF); LAS bf16_t* Vt = Kt + 4608;
                    u32x4 pkA[4], pkB[4]; f32x16 pA0, pA1, pB0, pB1;
                    ATT_S(Kt); ATT_SM(t == 0); ATT_PV(Vt); }
                slot = slot_next;
                __syncthreads();
            }
        } else {
            int slot = 0, slot_prev = 0;
            u32x4 pkA[4], pkB[4];
#pragma unroll
            for (int i = 0; i < 4; ++i) { pkA[i] = (u32x4){0u, 0u, 0u, 0u}; pkB[i] = (u32x4){0u, 0u, 0u, 0u}; }
#pragma nounroll
            for (int t = 0; t <= NTL; ++t) {
                const int slot_next = (slot == 2) ? 0 : slot + 1;
                ATT_STAGE(t);
                if (t > 0) { LAS bf16_t* Vp = (LAS bf16_t*)(lds + slot_prev * ATT_BUF) + 4608; ATT_PV(Vp); }
                if (t < NTL) { LAS bf16_t* Kt = (LAS bf16_t*)(lds + slot * ATT_BUF); f32x16 pA0, pA1, pB0, pB1; ATT_S(Kt); ATT_SM(t == 0); }
                slot_prev = slot; slot = slot_next;
                __syncthreads();
            }
        }
#define ATT_STORE(o0_, o1_, l_, qr_) do { l_ += shx(l_, 32, lane); const float inv = 1.0f / l_; bf16_t* orow = O + (size_t)(qr_) * DM + head * 64 + 4 * hi; \
        _Pragma("unroll") for (int g = 0; g < 4; ++g) { \
            *(u32x2*)(orow + 8 * g) = (u32x2){pk2(o0_[4 * g] * inv, o0_[4 * g + 1] * inv), pk2(o0_[4 * g + 2] * inv, o0_[4 * g + 3] * inv)}; \
            *(u32x2*)(orow + 32 + 8 * g) = (u32x2){pk2(o1_[4 * g] * inv, o1_[4 * g + 1] * inv), pk2(o1_[4 * g + 2] * inv, o1_[4 * g + 3] * inv)}; } } while (0)
        ATT_STORE(oA0, oA1, lA, qrow);
        ATT_STORE(oB0, oB1, lB, qrow + 32);
    }
}

__global__ void __launch_bounds__(512) hybrid_fwd(KArgs ka) {
    extern __shared__ __attribute__((aligned(16))) unsigned char lds_raw[];
    LAS unsigned char* lds_k = (LAS unsigned char*)lds_raw;
    cg::grid_group grid = cg::this_grid();
    const int tid_k = threadIdx.x, blk_k = blockIdx.x, nblk_k = gridDim.x; const int wave_k = __builtin_amdgcn_readfirstlane(tid_k >> 6);
#ifndef PHMASK
#define PHMASK 0xFFFF
#endif
#define EN(n) (((PHMASK) >> (n)) & 1)
#ifndef REPMASK
#define REPMASK 0
#endif
#define REPS(n) for (int rep_ = 0; rep_ < 1 + (((REPMASK) >> (n)) & 1); ++rep_)
    bool seq_done = false; (void)seq_done;
    volatile LAS unsigned* bst = (volatile LAS unsigned*)(lds_k + LDS_BYTES - 16);
    if (tid_k < 4) bst[tid_k] = 0u;
    __syncthreads();
    XcdBarrier xbar = xcd_barrier_post((unsigned*)ka.ws, bst);
    for (int ph = ka.lo; ph < ka.hi; ++ph) {
        int tid, wv_ = wave_k; asm volatile("" : "+s"(wv_)); asm volatile("v_mbcnt_lo_u32_b32 %0, -1, 0\n\tv_mbcnt_hi_u32_b32 %0, -1, %0" : "=v"(tid)); tid += wv_ * 64; int blk = blk_k, nblk = nblk_k; unsigned ldsu = 0; KAP a = (KAP)__builtin_amdgcn_kernarg_segment_ptr(); asm volatile("" : "+s"(a)); unsigned char* ws = a->ws; float* X = a->out;
        asm volatile("" : "+v"(tid)); asm volatile("" : "+s"(blk)); asm volatile("" : "+s"(nblk)); asm volatile("" : "+s"(ws)); asm volatile("" : "+s"(X)); asm volatile("" : "+s"(ldsu));
        const int lane = tid & 63, wave = __builtin_amdgcn_readfirstlane(tid >> 6);
        LAS unsigned char* lds = lds_k + ldsu;
        const float* MOD = (const float*)(ws + WS_MOD); bf16_t* H = (bf16_t*)(ws + WS_H);
        int kind, half = 0, layer = 0, full = 0;
        if (ph == 0) kind = 0;
        else if (ph <= 15) { const int st = ph <= 8 ? ph - 1 : ph - 8; half = ph > 8; kind = st + 1; }
        else if (ph <= 19 || ph >= 25) { layer = ph >= 25; const int idx = ph - (layer ? 25 : 16);
            if (idx == 0) kind = 12; else if (idx == 1) { kind = 13; full = layer; } else { kind = 14; if (layer) full = 1; else half = idx - 2; } }
        else { layer = 1; kind = ph == 20 ? 15 : ph == 21 ? 16 : ph == 22 ? 9 : ph == 23 ? 10 : 17; }
        const int grow0 = half * HROWS;
        const float* modl = MOD + layer * 9 * 6144;
        if (kind == 0) { if (EN(0)) REPS(0) phase_prologue(a, lds, tid, lane, wave, blk, nblk); }
        else if (kind == 1 || kind == 12 || kind == 15) {
            const float* x0; const float* x1; const float* nw; int sh_off, row0, nrows;
            if (kind == 1) { x0 = a->in[0]; x1 = a->in[1]; nw = a->in[10]; sh_off = 0; row0 = grow0; nrows = HROWS; }
            else if (kind == 15) { x0 = X; x1 = X + (size_t)PROWS * DM; nw = a->in[10] + DM; sh_off = 0; row0 = HROWS; nrows = HROWS; }
            else { x0 = X; x1 = X + (size_t)PROWS * DM; nw = a->in[11] + layer * DM; sh_off = 3072; row0 = layer ? 0 : HROWS; nrows = layer ? MROWS : HROWS; }
            if (EN(1)) REPS(1) phase_norm(x0, x1, nw, modl, sh_off, sh_off + 1024, row0, nrows, H + (size_t)(kind == 1 ? 0 : row0) * DM, (float*)nullptr, lane, wave, blk, nblk);
        }
        else if (kind == 2 || kind == 13 || kind == 16) {
            const bf16_t* Ap; const bf16_t* Bp; bf16_t* Op; int Mr, Nc, ldo;
            if (kind == 2) { Ap = H; Bp = (const bf16_t*)(ws + WS_WIN); Mr = HROWS; Nc = NPROJ_PAD; Op = (bf16_t*)(ws + WS_PROJ); ldo = NPROJ; }
            else if (kind == 13) { Ap = H + (size_t)grow0 * DM; Bp = (const bf16_t*)(ws + (layer ? WS_WUP1 : WS_WUP0)); Mr = full ? MROWS : HROWS; Nc = FFU; Op = (bf16_t*)(ws + (full ? WS_ACT1 : WS_ACT)); ldo = FFH; }
            else { Ap = H; Bp = (const bf16_t*)(ws + WS_WQKV); Mr = MROWS; Nc = NQKV; Op = (bf16_t*)(ws + WS_QKV); ldo = NQKV; }
            if (kind == 13) { if (EN(11)) { pg8::Gemm g{Ap, Bp, Mr, Nc, 1024, 1}; pg8::StaticOrder S; S.init(Mr, Nc, nblk, blk);
                pg8::EpiConvFfn E{Op, (float*)(ws + WS_EDGE), a->in[13] + (size_t)layer * 3 * FFU, a->in[14] + (size_t)layer * FFU, 0, (LAS float*)(lds + 131072)};
                pg8::gemm_phase<pg8::EpiConvFfn, pg8::StaticOrder, true, true>(lds, g, S, E, tid); } }
            else if (EN(2)) REPS(2) { pg8::Gemm g{Ap, Bp, Mr, Nc, 1024, 1}; pg8::StaticOrder S; S.init(Mr, Nc, nblk, blk);
                pg8::EpiStoreBf16 E{Op, ldo, ldo}; pg8::gemm_phase<pg8::EpiStoreBf16, pg8::StaticOrder, true, true>(lds, g, S, E, tid); }
        }
        else if (kind == 8 || kind == 14 || kind == 17) {
            const bf16_t* Ap; const bf16_t* Bp; const float* b0; const float* b1; const float* gp; int Mr, Kd, roff;
            if (kind == 8) { Ap = (const bf16_t*)(ws + WS_YG); Bp = (const bf16_t*)(ws + WS_WOUT); Mr = HROWS; Kd = 2048; b0 = a->in[0]; b1 = a->in[1]; gp = modl + 2048; roff = grow0; }
            else if (kind == 14) { Ap = (const bf16_t*)(ws + ((half || full) ? WS_ACT1 : WS_ACT)); Bp = (const bf16_t*)(ws + (layer ? WS_WDN1 : WS_WDN0)); Mr = full ? MROWS : HROWS; Kd = FFH; b0 = X; b1 = X + (size_t)PROWS * DM; gp = modl + 5120; roff = grow0; }
            else { Ap = (const bf16_t*)(ws + WS_O); Bp = (const bf16_t*)(ws + WS_WO); Mr = MROWS; Kd = 1024; b0 = X; b1 = X + (size_t)PROWS * DM; gp = modl + 2048; roff = 0; }
            if (kind == 14 && EN(8)) {
                pg8::StaticOrder S0; S0.init(Mr, DM, nblk, blk); pg8::Unit uu;
                for (int i = 0; S0.next(i, uu); ++i) ffn_seam_fixup((const float*)(ws + WS_EDGE), (bf16_t*)(ws + ((half || full) ? WS_ACT1 : WS_ACT)) + (size_t)uu.pm * 256 * FFH, a->in[13] + (size_t)layer * 3 * FFU, a->in[14] + (size_t)layer * FFU, (grow0 >> 8) + uu.pm, tid);
                asm volatile("s_waitcnt vmcnt(0)" ::: "memory"); __syncthreads(); }
            if (EN(8)) { pg8::Gemm g{Ap, Bp, Mr, DM, Kd, 1}; pg8::StaticOrder S; S.init(Mr, DM, nblk, blk);
                pg8::EpiResid E{b0, b1, X, gp, roff}; pg8::gemm_phase<pg8::EpiResid, pg8::StaticOrder, true, true>(lds, g, S, E, tid); }
            if (kind == 14 && half == 0 && !full && EN(11)) {
                pg8::Gemm g{H + (size_t)HROWS * DM, (const bf16_t*)(ws + (layer ? WS_WUP1 : WS_WUP0)), HROWS, FFU, 1024, 1}; pg8::SkewOrder S; S.init(HROWS, FFU, nblk, blk);
                pg8::EpiConvFfn E{(bf16_t*)(ws + WS_ACT1), (float*)(ws + WS_EDGE), a->in[13] + (size_t)layer * 3 * FFU, a->in[14] + (size_t)layer * FFU, HROWS, (LAS float*)(lds + 131072)};
                pg8::gemm_phase<pg8::EpiConvFfn, pg8::SkewOrder, true, true>(lds, g, S, E, tid); }
            if (EN(1) && ((kind == 8 && half == 1) || (kind == 14 && half == 1 && layer == 0))) {
                const int skip = (nblk == 256) ? 64 : 0;
                if (blk >= skip) { if (kind == 8) phase_norm(X, X + (size_t)PROWS * DM, a->in[11], MOD, 3072, 4096, 0, HROWS, H, (float*)nullptr, lane, wave, blk - skip, nblk - skip);
                    else phase_norm(X, X + (size_t)PROWS * DM, a->in[10] + DM, MOD + 9 * 6144, 0, 1024, 0, HROWS, H, (float*)nullptr, lane, wave, blk - skip, nblk - skip); } }
            if (kind == 8 && half == 0 && EN(1)) {
                const int skip = (nblk == 256) ? 64 : 0;
                if (blk >= skip) phase_norm(a->in[0], a->in[1], a->in[10], modl, 0, 1024, HROWS, HROWS, H, (float*)nullptr, lane, wave, blk - skip, nblk - skip); }
        }
        else if (kind == 3) { if (EN(3)) REPS(3) { phase_conv_xbc((const bf16_t*)(ws + WS_PROJ), H, a->in[20], a->in[21], grow0, tid, blk, nblk); phase_coeffs(a, lane, wave, blk, nblk); } }
        else if (kind == 4) { if (EN(4)) REPS(4) phase_pass1(a, lds, tid, lane, wave, blk, nblk); }
        else if (kind == 5) { if (EN(5)) phase_pass2(a, half, tid, blk, nblk); }
        else if (kind == 6) { if (EN(6)) { phase_pass3(a, lds, tid, lane, wave, blk, nblk, false);
#ifdef P3REP
            if (half == 0) phase_pass3(a, lds, tid, lane, wave, blk, nblk, true);
#endif
        } }
        else if (kind == 7) { if (EN(7)) REPS(7) phase_gate(a, lane, wave, blk, nblk); }
        else if (kind == 9) { if (EN(9)) phase_attn_prep(a, lds, tid, lane, wave, blk, nblk); }
        else if (kind == 10) { if (EN(10)) REPS(10) phase_attn(a, lds, tid, lane, wave, blk, nblk); }
#ifdef XSYNC
        if (ph == 20) { for (int i_ = 0; i_ < XSYNC; ++i_) xcd_barrier(xbar); }
#endif
#ifdef SEQ_BEGIN
        if (ph == SEQ_END && !seq_done) { seq_done = true; ph = SEQ_BEGIN - 1; }
#endif
        if (ph + 1 < ka.hi) { if (ka.hi > 1000) grid.sync(); else xcd_barrier(xbar); }
    }
}
constexpr int NPHASES = 1 + 15 + 4 + 5 + 3;

#ifndef MK_PER_PHASE
#define MK_PER_PHASE 0
#endif
extern "C" void kernel_launch(void* const* d_in, const int* in_sizes, int n_in, void* d_out, int out_size, void* d_ws, size_t ws_size, hipStream_t stream) {
    static int grid = 0;
    if (grid == 0) {
        if (n_in != 30 || ws_size < WS_NEED) { fprintf(stderr, "kernel_launch: unexpected n_in %d / ws_size %zu\n", n_in, ws_size); grid = -1; return; }
        int dev = 0, cus = 0, per_cu = 0;
        hipGetDevice(&dev); hipDeviceGetAttribute(&cus, hipDeviceAttributeMultiprocessorCount, dev);
        if (hipFuncSetAttribute((const void*)hybrid_fwd, hipFuncAttributeMaxDynamicSharedMemorySize, LDS_BYTES) != hipSuccess) { fprintf(stderr, "kernel_launch: hipFuncSetAttribute failed\n"); grid = -1; return; }
        if (hipOccupancyMaxActiveBlocksPerMultiprocessor(&per_cu, (const void*)hybrid_fwd, 512, LDS_BYTES) != hipSuccess || per_cu < 1) { fprintf(stderr, "kernel_launch: occupancy query says %d\n", per_cu); per_cu = 1; }
        (void)hipGetLastError();
        grid = cus * per_cu;
        if (grid > 256) grid = 256;
        grid -= grid % 8;
    }
    if (grid <= 0) return;
    if (hipMemsetAsync(d_ws, 0, 16384, stream) != hipSuccess) { fprintf(stderr, "kernel_launch: memset of the barrier words failed\n"); return; }
    KArgs a{};
    for (int i = 0; i < 30; ++i) a.in[i] = (const float*)d_in[i];
    a.out = (float*)d_out; a.ws = (unsigned char*)d_ws;
#if MK_PER_PHASE
    for (int p = 0; p < NPHASES; ++p) { a.lo = p; a.hi = p + 1; hipLaunchKernelGGL(hybrid_fwd, dim3(grid), dim3(512), LDS_BYTES, stream, a); }
#else
    a.lo = 0; a.hi = NPHASES;
    void* args[] = {&a};
    hipError_t e = hipLaunchCooperativeKernel((const void*)hybrid_fwd, dim3(grid), dim3(512), args, LDS_BYTES, stream);
    if (e != hipSuccess) fprintf(stderr, "cooperative launch failed: %s (grid %d)\n", hipGetErrorString(e), grid);
#endif
}
```
